# Optimizing an MI355X kernel written in HIP

```python
import jax, jax.numpy as jnp
from jax import lax
import numpy as np

D_MODEL = 1024
BATCH = 2
SEQ = 8192
DEPTH = 1

N_META = 16
RG_WIDTH = (4 * D_MODEL // 3) // 128 * 128
RG_BLOCKS = 16
RG_BLOCK = RG_WIDTH // RG_BLOCKS
RG_CONV = 4
RG_C = 8.0
HG_HEADS = 8
HG_DK = D_MODEL // HG_HEADS
HG_DV = D_MODEL // HG_HEADS
HG_WIDTH = HG_HEADS * HG_DV
HG_CHUNK = 64
D_FF = ((8 * D_MODEL // 3 + 255) // 256) * 256
NORM_EPS = 1e-6
SPLITS = [RG_WIDTH, RG_WIDTH, HG_WIDTH, HG_WIDTH, HG_WIDTH, HG_WIDTH, D_MODEL, D_MODEL]
D_IN = sum(SPLITS)

kernel_name = "hybrid_rglru_hgrn2_gated_block"


def _rmsnorm(x, g):
    xf = x.astype(jnp.float32)
    y = xf * lax.rsqrt(jnp.mean(xf * xf, axis=-1, keepdims=True) + NORM_EPS)
    return (y * g.astype(jnp.float32)).astype(x.dtype)


def _causal_depthwise_conv(x, w, b):
    k = w.shape[0]
    y = lax.conv_general_dilated(
        x, w[:, None, :], window_strides=(1,), padding=[(k - 1, 0)],
        dimension_numbers=("NWC", "WIO", "NWC"), feature_group_count=x.shape[-1])
    return y + b


def _rg_lru(x, w_a, b_a, w_x, b_x, lam):
    bsz, t, w = x.shape
    xb = x.reshape(bsz, t, RG_BLOCKS, RG_BLOCK)
    r = jax.nn.sigmoid(jnp.einsum("btnd,nde->btne", xb, w_a).reshape(bsz, t, w) + b_a)
    i = jax.nn.sigmoid(jnp.einsum("btnd,nde->btne", xb, w_x).reshape(bsz, t, w) + b_x)
    log_a = -RG_C * r.astype(jnp.float32) * jax.nn.softplus(-lam.astype(jnp.float32))
    a = jnp.exp(log_a)
    u = jnp.sqrt(-jnp.expm1(2.0 * log_a)) * (i * x).astype(jnp.float32)

    def combine(left, right):
        a1, b1 = left
        a2, b2 = right
        return a1 * a2, a2 * b1 + b2

    _, h = lax.associative_scan(combine, (a, u), axis=1)
    return h.astype(x.dtype)


def _hgrn2_chunkwise(q, k, v, log_f):
    bsz, nh, t, dk = q.shape
    dv = v.shape[-1]
    n = t // HG_CHUNK

    def to_chunks(z):
        z = z.astype(jnp.float32).reshape(bsz, nh, n, HG_CHUNK, z.shape[-1])
        return jnp.moveaxis(z, 2, 0)

    causal = jnp.tril(jnp.ones((HG_CHUNK, HG_CHUNK), dtype=bool))

    def step(s_prev, inp):
        qc, kc, vc, gc = inp
        bcum = jnp.cumsum(gc, axis=-2)
        o_inter = jnp.einsum("bhtk,bhkv->bhtv", qc * jnp.exp(bcum), s_prev)
        diff = bcum[:, :, :, None, :] - bcum[:, :, None, :, :]
        decay = jnp.exp(jnp.where(causal[:, :, None], diff, -jnp.inf))
        attn = jnp.einsum("bhtk,bhtsk,bhsk->bhts", qc, decay, kc)
        o_intra = jnp.einsum("bhts,bhsv->bhtv", attn, vc)
        b_last = bcum[:, :, -1:, :]
        k_dec = kc * jnp.exp(b_last - bcum)
        s_new = jnp.exp(b_last[:, :, 0, :])[..., None] * s_prev + jnp.einsum("bhsk,bhsv->bhkv", k_dec, vc)
        return s_new, o_inter + o_intra

    s0 = jnp.zeros((bsz, nh, dk, dv), jnp.float32)
    _, o = lax.scan(step, s0, (to_chunks(q), to_chunks(k), to_chunks(v), to_chunks(log_f)))
    o = jnp.moveaxis(o, 0, 2).reshape(bsz, nh, t, dv)
    return o


def setup_inputs(seed: int = 0) -> dict:
    key = jax.random.key(seed)
    ks = jax.random.split(key, 24)
    f32 = jnp.float32

    def nrm(k, shape, scale):
        return jax.random.normal(k, shape, f32) * scale

    a_c = jax.random.uniform(ks[10], (DEPTH, RG_WIDTH), f32, 0.9, 0.999)
    p = a_c ** (1.0 / RG_C)
    rg_lambda = jnp.log(p) - jnp.log1p(-p)
    return {
        "x": nrm(ks[0], (BATCH, SEQ, D_MODEL), 1.0),
        "meta_tokens": nrm(ks[1], (N_META, D_MODEL), 1.0),
        "norm1_g": 1.0 + nrm(ks[2], (DEPTH, D_MODEL), 0.01),
        "w_in": nrm(ks[3], (DEPTH, D_MODEL, D_IN), D_MODEL ** -0.5),
        "conv_w": nrm(ks[4], (DEPTH, RG_CONV, RG_WIDTH), RG_CONV ** -0.5),
        "conv_b": nrm(ks[5], (DEPTH, RG_WIDTH), 0.01),
        "rg_wa": nrm(ks[6], (DEPTH, RG_BLOCKS, RG_BLOCK, RG_BLOCK), RG_BLOCK ** -0.5),
        "rg_ba": nrm(ks[7], (DEPTH, RG_WIDTH), 0.01),
        "rg_wx": nrm(ks[8], (DEPTH, RG_BLOCKS, RG_BLOCK, RG_BLOCK), RG_BLOCK ** -0.5),
        "rg_bx": nrm(ks[9], (DEPTH, RG_WIDTH), 0.01),
        "rg_lambda": rg_lambda,
        "hg_lb_logits": nrm(ks[11], (DEPTH + 1, HG_HEADS * HG_DK), 1.0),
        "hg_norm_g": 1.0 + nrm(ks[12], (DEPTH, HG_DV), 0.01),
        "w_proj_a": nrm(ks[13], (DEPTH, RG_WIDTH, D_MODEL), RG_WIDTH ** -0.5),
        "w_proj_b": nrm(ks[14], (DEPTH, HG_WIDTH, D_MODEL), HG_WIDTH ** -0.5),
        "w_out": nrm(ks[15], (DEPTH, D_MODEL, D_MODEL), D_MODEL ** -0.5),
        "norm2_g": 1.0 + nrm(ks[16], (DEPTH, D_MODEL), 0.01),
        "w_ffn_in": nrm(ks[17], (DEPTH, D_MODEL, 2 * D_FF), D_MODEL ** -0.5),
        "w_ffn_down": nrm(ks[18], (DEPTH, D_FF, D_MODEL), D_FF ** -0.5),
        "norm_f_g": 1.0 + nrm(ks[19], (D_MODEL,), 0.01),
    }


def reference(x, meta_tokens, norm1_g, w_in, conv_w, conv_b, rg_wa, rg_ba, rg_wx, rg_bx,
              rg_lambda, hg_lb_logits, hg_norm_g, w_proj_a, w_proj_b, w_out, norm2_g,
              w_ffn_in, w_ffn_down, norm_f_g):
    bsz = x.shape[0]
    meta = jnp.broadcast_to(meta_tokens[None].astype(x.dtype), (bsz, N_META, D_MODEL))
    h = jnp.concatenate([meta, x], axis=1)
    t_total = h.shape[1]
    pad = HG_CHUNK - N_META

    lower_bounds = jnp.cumsum(jax.nn.softmax(hg_lb_logits.astype(jnp.float32), axis=0), axis=0)
    split_idx = list(np.cumsum(SPLITS)[:-1])

    for l in range(DEPTH):
        hn = _rmsnorm(h, norm1_g[l])
        proj = jnp.einsum("btd,de->bte", hn, w_in[l])
        a_x, a_gate, b_q, b_f, b_i, b_g, gate_a, gate_b = jnp.split(proj, split_idx, axis=-1)

        a_x = _causal_depthwise_conv(a_x, conv_w[l], conv_b[l])
        y_a = _rg_lru(a_x, rg_wa[l], rg_ba[l], rg_wx[l], rg_bx[l], rg_lambda[l]) * jax.nn.gelu(a_gate)

        lb = lower_bounds[l].astype(jnp.float32)
        f_logit = b_f.astype(jnp.float32)
        log_f = jnp.log(lb + (1.0 - lb) * jax.nn.sigmoid(f_logit))
        k_in = (1.0 - lb) * jax.nn.sigmoid(-f_logit)
        q_in = jax.nn.silu(b_q)

        def heads(z, d):
            z = z.reshape(bsz, t_total, HG_HEADS, d).transpose(0, 2, 1, 3)
            return jnp.pad(z, ((0, 0), (0, 0), (pad, 0), (0, 0)))

        o_b = _hgrn2_chunkwise(heads(q_in, HG_DK), heads(k_in, HG_DK),
                               heads(b_i, HG_DV), heads(log_f, HG_DK))
        o_b = o_b[:, :, pad:, :].transpose(0, 2, 1, 3)
        g_heads = b_g.reshape(bsz, t_total, HG_HEADS, HG_DV)
        y_b = (_rmsnorm(o_b, hg_norm_g[l]).astype(h.dtype) * jax.nn.silu(g_heads)).reshape(bsz, t_total, HG_WIDTH)

        merged = (jax.nn.sigmoid(gate_a) * jnp.einsum("btw,wd->btd", y_a, w_proj_a[l])
                  + jax.nn.sigmoid(gate_b) * jnp.einsum("btw,wd->btd", y_b, w_proj_b[l]))
        h = h + jnp.einsum("btd,de->bte", merged, w_out[l])

        hn = _rmsnorm(h, norm2_g[l])
        gu = jnp.einsum("btd,df->btf", hn, w_ffn_in[l])
        g_ff, u_ff = jnp.split(gu, [D_FF], axis=-1)
        h = h + jnp.einsum("btf,fd->btd", jax.nn.silu(g_ff) * u_ff, w_ffn_down[l])

    h = _rmsnorm(h, norm_f_g)
    return h[:, N_META:, :]
```

```cpp
#include <hip/hip_runtime.h>
#include <hip/hip_cooperative_groups.h>
#include <cstdio>
#include <cstdint>
namespace cg = cooperative_groups;
namespace pg8 {
#define PG8_LAS __attribute__((address_space(3)))
typedef unsigned short bf16_t;
typedef short bf16x8 __attribute__((ext_vector_type(8)));
typedef float f32x4 __attribute__((ext_vector_type(4)));
typedef unsigned u32x4 __attribute__((ext_vector_type(4)));
constexpr int BM = 256, BK = 64, HALF = 128, HTB = HALF * BK * 2  , STAGE_BYTES = 8 * HTB, NXCD = 8, WGM = 8;

__host__ __device__ __forceinline__ int lds_byte(int r, int c) { const int st = (r >> 4) * 2 + (c >> 5), rr = r & 15, cc = c & 31, ob = rr * 64 + cc * 2; return st * 1024 + (ob ^ (((ob >> 9) & 1) << 5)); }
__host__ __device__ __forceinline__ void stage_rc(int b, int& R, int& C) { const int st = b / 1024, sb = b % 1024, swz = sb ^ (((sb >> 9) & 1) << 5); R = (st >> 1) * 16 + swz / 64; C = (st & 1) * 32 + (swz % 64) / 2; }
__host__ __device__ __forceinline__ int perm32(int rho) { const int n = rho >> 4, i = rho & 15; return 8 * (i >> 2) + 4 * n + (i & 3); }

struct Unit { int pm, pn; };
struct Gemm { const bf16_t* A; const bf16_t* Bt; int M, N, K; };

struct StaticOrder {
    int nM, nN, nwg, G, c;
    __host__ __device__ void init(int M, int N, int G_, int c_) { nM = M / BM; nN = N / BM; nwg = nM * nN; G = G_; c = c_; }
    __host__ __device__ bool next(int i, Unit& u) const {
        const long L = (long)i * G + c; if (L >= nwg) return false;
        int wgid = (int)L; { const int q = nwg / NXCD, r = nwg % NXCD, xcd = wgid % NXCD, off = wgid / NXCD; wgid = (xcd < r ? xcd * (q + 1) : r * (q + 1) + (xcd - r) * q) + off; }
        const int nig = WGM * nN, gid = wgid / nig, fm = gid * WGM, gsz = (nM - fm) < WGM ? (nM - fm) : WGM;
        u.pm = fm + ((wgid % nig) % gsz); u.pn = (wgid % nig) / gsz; return true;
    }
    __device__ __forceinline__ void a_ready(const Unit&) const {}
    __device__ __forceinline__ void done(const Unit&) const {}
};
__device__ __forceinline__ unsigned cvt_pk_bf16(float lo, float hi) { unsigned r; asm volatile("v_cvt_pk_bf16_f32 %0, %1, %2" : "=v"(r) : "v"(lo), "v"(hi)); return r; }
template <class Epi, class Sched, bool ALIGN_EPI = false, bool SP2 = false>
__device__ __forceinline__ void gemm_phase(PG8_LAS unsigned char* lds, const Gemm g, const Sched& S, const Epi& E) {
    int tid_ = threadIdx.x; asm volatile("" : "+v"(tid_));
    const int tid = tid_, wid = __builtin_amdgcn_readfirstlane(tid >> 6), lane = tid & 63, wr = wid >> 2, wc = wid & 3, fr = lane & 15, fq = lane >> 4;
    const int K = g.K, nt = K / BK;
    unsigned voffA[2], voffB[2];
#pragma unroll
    for (int i = 0; i < 2; ++i) { int R, C; stage_rc(tid * 16 + i * 8192, R, C); const int Rb = Epi::PERM ? ((R & ~31) + perm32(R & 31)) : R;
        voffA[i] = (unsigned)(R * K + C) * 2u; voffB[i] = (unsigned)(Rb * K + C) * 2u; }
    const size_t kstep = (size_t)(BK * 2);
    const size_t hstep = (size_t)HALF * K * 2;
    const size_t tstep = 2 * hstep;
    const unsigned ldsw = (unsigned)wid * 1024u;
    const int aoff = lds_byte(wr * 64 + fr, fq * 8), boff = lds_byte(wc * 32 + fr, fq * 8);
#define PG8_SA(b, h) (((b) * 2 + (h)) * HTB)
#define PG8_SB(b, h) ((4 + (b) * 2 + (h)) * HTB)
#define PG8_STAGE(bufoff, gbase, voff) do { _Pragma("unroll") for (int _i = 0; _i < 2; ++_i) \
        __builtin_amdgcn_global_load_lds((const unsigned*)((const char*)(gbase) + (voff)[_i]), (PG8_LAS unsigned*)(lds + (bufoff) + ldsw + _i * 8192), 16, 0, 0); } while (0)
#define PG8_LDA(dst, b, h) do { _Pragma("unroll") for (int m = 0; m < 4; ++m) _Pragma("unroll") for (int k = 0; k < 2; ++k) dst[m][k] = *(const PG8_LAS bf16x8*)(lds + PG8_SA(b, h) + aoff + m * 2048 + k * 1024); } while (0)
#define PG8_LDB(dst, b, h) do { _Pragma("unroll") for (int n = 0; n < 2; ++n) _Pragma("unroll") for (int k = 0; k < 2; ++k) dst[n][k] = *(const PG8_LAS bf16x8*)(lds + PG8_SB(b, h) + boff + n * 2048 + k * 1024); } while (0)
#define PG8_MMA(ai, bj, At, Bt) do { __builtin_amdgcn_s_setprio(1); _Pragma("unroll") for (int m = 0; m < 4; ++m) _Pragma("unroll") for (int n = 0; n < 2; ++n) _Pragma("unroll") for (int k = 0; k < 2; ++k) \
        acc[ai][bj][m][n] = __builtin_amdgcn_mfma_f32_16x16x32_bf16(Bt[n][k], At[m][k], acc[ai][bj][m][n], 0, 0, 0); __builtin_amdgcn_s_setprio(0); } while (0)
#define PG8_WAIT_V(n) asm volatile("s_waitcnt vmcnt(" #n ")" ::: "memory")
#define PG8_WAIT_L(n) asm volatile("s_waitcnt lgkmcnt(" #n ")" ::: "memory")
#define PG8_BAR __builtin_amdgcn_s_barrier()
#define PG8_SCHED __builtin_amdgcn_sched_barrier(0)
    Unit cur, nxt; int ui = 0;
    if (!S.next(0, cur)) return;
    f32x4 acc[2][2][4][2];
#pragma unroll
    for (int a = 0; a < 2; ++a)
#pragma unroll
        for (int b = 0; b < 2; ++b)
#pragma unroll
            for (int m = 0; m < 4; ++m)
#pragma unroll
                for (int n = 0; n < 2; ++n) acc[a][b][m][n] = (f32x4){0.f, 0.f, 0.f, 0.f};
    bf16x8 At[4][2], B0[2][2], B1[2][2];
    const char* cA = (const char*)g.A + (size_t)cur.pm * tstep; const char* cB = (const char*)g.Bt + (size_t)cur.pn * tstep;
    S.a_ready(cur);
    if constexpr (SP2) {
        PG8_STAGE(PG8_SB(0, 0), cB, voffB); PG8_STAGE(PG8_SB(0, 1), cB + hstep, voffB); PG8_STAGE(PG8_SA(0, 0), cA, voffA); PG8_STAGE(PG8_SA(0, 1), cA + hstep, voffA);
        if (wr == 1) PG8_BAR;
        PG8_WAIT_V(2); PG8_BAR;
        PG8_STAGE(PG8_SB(1, 0), cB + kstep, voffB); PG8_STAGE(PG8_SA(1, 0), cA + kstep, voffA); PG8_STAGE(PG8_SB(1, 1), cB + hstep + kstep, voffB);
        PG8_WAIT_V(6); PG8_BAR;
    } else {
        PG8_STAGE(PG8_SB(0, 0), cB, voffB); PG8_STAGE(PG8_SA(0, 0), cA, voffA); PG8_STAGE(PG8_SB(0, 1), cB + hstep, voffB); PG8_STAGE(PG8_SA(0, 1), cA + hstep, voffA);
        if (wr == 1) PG8_BAR;
        PG8_WAIT_V(4); PG8_BAR;
        PG8_STAGE(PG8_SB(1, 0), cB + kstep, voffB); PG8_STAGE(PG8_SA(1, 0), cA + kstep, voffA); PG8_STAGE(PG8_SB(1, 1), cB + hstep + kstep, voffB);
        PG8_WAIT_V(6); PG8_BAR;
    }
    for (;;) {
        const bool has_next = S.next(ui + 1, nxt);
        const char* nA = has_next ? (const char*)g.A + (size_t)nxt.pm * tstep : cA; const char* nB = has_next ? (const char*)g.Bt + (size_t)nxt.pn * tstep : cB;
        for (int t = 0; t < nt; t += 2) {
            const bool last = (t == nt - 2);
            const char* a1 = cA + (size_t)(t + 1) * kstep;
            const char* a2 = last ? nA : cA + (size_t)(t + 2) * kstep; const char* b2 = last ? nB : cB + (size_t)(t + 2) * kstep;
            const char* a3 = a2 + kstep; const char* b3 = b2 + kstep;
            if (last && has_next) S.a_ready(nxt);
            if constexpr (SP2) {
            PG8_LDB(B0, 0, 0); PG8_LDB(B1, 0, 1); PG8_SCHED; PG8_LDA(At, 0, 0); PG8_STAGE(PG8_SA(1, 1), a1 + hstep, voffA);
            PG8_WAIT_V(8); PG8_WAIT_L(0); PG8_BAR; PG8_MMA(0, 0, At, B0); PG8_MMA(0, 1, At, B1); PG8_BAR; PG8_SCHED;
            PG8_LDA(At, 0, 1); PG8_STAGE(PG8_SB(0, 0), b2, voffB); PG8_STAGE(PG8_SB(0, 1), b2 + hstep, voffB); PG8_STAGE(PG8_SA(0, 0), a2, voffA);
            PG8_WAIT_V(8); PG8_WAIT_L(0); PG8_BAR; PG8_MMA(1, 0, At, B0); PG8_MMA(1, 1, At, B1); PG8_BAR; PG8_SCHED;
            PG8_LDB(B0, 1, 0); PG8_LDB(B1, 1, 1); PG8_SCHED; PG8_LDA(At, 1, 0); PG8_STAGE(PG8_SA(0, 1), a2 + hstep, voffA);
            PG8_WAIT_V(8); PG8_WAIT_L(0); PG8_BAR; PG8_MMA(0, 0, At, B0); PG8_MMA(0, 1, At, B1); PG8_BAR; PG8_SCHED;
            PG8_LDA(At, 1, 1); PG8_STAGE(PG8_SB(1, 0), b3, voffB); PG8_STAGE(PG8_SB(1, 1), b3 + hstep, voffB); PG8_STAGE(PG8_SA(1, 0), a3, voffA);
            PG8_WAIT_V(8); PG8_WAIT_L(0); PG8_BAR; PG8_MMA(1, 0, At, B0); PG8_MMA(1, 1, At, B1); PG8_BAR; PG8_SCHED;
            } else {
            PG8_LDB(B0, 0, 0); PG8_SCHED; PG8_LDA(At, 0, 0); PG8_STAGE(PG8_SA(1, 1), a1 + hstep, voffA);
            PG8_WAIT_L(8); PG8_BAR; PG8_WAIT_L(0); PG8_MMA(0, 0, At, B0); PG8_BAR; PG8_SCHED;
            PG8_LDB(B1, 0, 1); PG8_STAGE(PG8_SB(0, 0), b2, voffB);
            PG8_BAR; PG8_WAIT_L(0); PG8_MMA(0, 1, At, B1); PG8_BAR;
            PG8_LDA(At, 0, 1); PG8_STAGE(PG8_SA(0, 0), a2, voffA);
            PG8_BAR; PG8_WAIT_L(0); PG8_MMA(1, 0, At, B0); PG8_BAR; PG8_SCHED;
            PG8_STAGE(PG8_SB(0, 1), b2 + hstep, voffB);
            PG8_WAIT_V(6); PG8_BAR; PG8_MMA(1, 1, At, B1); PG8_BAR;
            PG8_LDB(B0, 1, 0); PG8_SCHED; PG8_LDA(At, 1, 0); PG8_STAGE(PG8_SA(0, 1), a2 + hstep, voffA);
            PG8_WAIT_L(8); PG8_BAR; PG8_WAIT_L(0); PG8_MMA(0, 0, At, B0); PG8_BAR; PG8_SCHED;
            PG8_LDB(B1, 1, 1); PG8_STAGE(PG8_SB(1, 0), b3, voffB);
            PG8_BAR; PG8_WAIT_L(0); PG8_MMA(0, 1, At, B1); PG8_BAR;
            PG8_LDA(At, 1, 1); PG8_STAGE(PG8_SA(1, 0), a3, voffA);
            PG8_BAR; PG8_WAIT_L(0); PG8_MMA(1, 0, At, B0); PG8_BAR; PG8_SCHED;
            PG8_STAGE(PG8_SB(1, 1), b3 + hstep, voffB);
            PG8_WAIT_V(6); PG8_BAR; PG8_MMA(1, 1, At, B1); PG8_BAR;
            }
        }
        if constexpr (ALIGN_EPI) { if (wr == 0) PG8_BAR; }
        if constexpr (!Epi::AFTER_DRAIN) { E(acc, cur, wr, wc, fr, fq); S.done(cur); }
        if (!has_next) break;
#pragma unroll
        for (int a = 0; a < 2; ++a)
#pragma unroll
            for (int b = 0; b < 2; ++b)
#pragma unroll
                for (int m = 0; m < 4; ++m)
#pragma unroll
                    for (int n = 0; n < 2; ++n) acc[a][b][m][n] = (f32x4){0.f, 0.f, 0.f, 0.f};
        cur = nxt; cA = nA; cB = nB; ++ui;
        if constexpr (ALIGN_EPI) { if (wr == 1) PG8_BAR; }
    }
    PG8_WAIT_V(0);
    if constexpr (!ALIGN_EPI) { if (wr == 0) PG8_BAR; }
    PG8_BAR;
    if constexpr (Epi::AFTER_DRAIN) { E.fused(acc, cur, wr, wc, fr, fq, lds, wid, lane); S.done(cur); }
#undef PG8_SA
#undef PG8_SB
#undef PG8_STAGE
#undef PG8_LDA
#undef PG8_LDB
#undef PG8_MMA
#undef PG8_WAIT_V
#undef PG8_WAIT_L
#undef PG8_BAR
#undef PG8_SCHED
}
}
using pg8::bf16_t; using pg8::bf16x8; using pg8::f32x4; using pg8::u32x4; using pg8::Unit; using pg8::cvt_pk_bf16;
#define LAS __attribute__((address_space(3)))
typedef unsigned u32x2 __attribute__((ext_vector_type(2)));

constexpr int MX = 16384, MT = 16640, DM = 1024, RGW = 1280, DFF = 2816, N1 = 6656;
constexpr float EPS = 1e-6f;
constexpr size_t MiB = (size_t)1 << 20;
constexpr size_t WS_WIN = 1 * MiB;
constexpr size_t WS_WPA = 18 * MiB;
constexpr size_t WS_WPB = WS_WPA + 2621440;
constexpr size_t WS_WOUT = WS_WPB + 2 * MiB;
constexpr size_t WS_WFI = WS_WOUT + 2 * MiB;
constexpr size_t WS_WFD = WS_WFI + 11 * MiB;
constexpr size_t WS_MISC = 41 * MiB;
constexpr size_t WS_GFRAG = WS_MISC;
constexpr size_t WS_RGAGG = WS_MISC + 512 * 1024;
constexpr size_t WS_RGAGM = WS_MISC + 1792 * 1024;
constexpr size_t WS_HGD = WS_MISC + 1856 * 1024;
constexpr size_t WS_HGSM = WS_MISC + 2112 * 1024;
constexpr size_t WS_XN = 44 * MiB;
constexpr size_t WS_AX = WS_XN + (size_t)MT * DM * 2;
constexpr size_t WS_AG = WS_AX + (size_t)MT * RGW * 2;
constexpr size_t WS_Q = WS_AG + (size_t)MX * RGW * 2;
constexpr size_t WS_F = WS_Q + (size_t)MX * DM * 2;
constexpr size_t WS_V = WS_F + (size_t)MT * DM * 2;
static_assert(WS_V + (size_t)MT * DM * 2 <= 256 * MiB, "ws map");
static_assert(WS_AG + (size_t)MX * DFF * 2 <= WS_V, "ACT overlay");
constexpr size_t WS_GA = WS_AX, WS_GB = WS_V, WS_T1 = WS_Q, WS_MG = WS_F;
constexpr size_t OUT_G = 0, OUT_HGS = 32 * MiB;
constexpr int LDS_BYTES = 147456;

struct Args { const float* in[20]; float* out; unsigned char* ws; int ph_lo, ph_hi; };

__device__ __forceinline__ float bf2f(unsigned short b) { return __uint_as_float(((unsigned)b) << 16); }
__device__ __forceinline__ float bflo(unsigned w) { return __uint_as_float(w << 16); }
__device__ __forceinline__ float bfhi(unsigned w) { return __uint_as_float(w & 0xffff0000u); }
__device__ __forceinline__ unsigned short f2bf(float f) { unsigned u = __float_as_uint(f); return (unsigned short)((u + 0x7fffu + ((u >> 16) & 1u)) >> 16); }
__device__ __forceinline__ float sigm(float x) { return __builtin_amdgcn_rcpf(1.f + __expf(-x)); }
__device__ __forceinline__ float wave_sum(float v) {
#pragma unroll
    for (int o = 1; o < 64; o <<= 1) v += __shfl_xor(v, o);
    return v;
}
#define LDS_WAIT() asm volatile("s_waitcnt lgkmcnt(0)" ::: "memory")
__device__ __forceinline__ int tok_row(int b, int s) { return s >= 0 ? b * 8192 + s : (s >= -16 ? 16400 + s : -1); }

__device__ __forceinline__ void transpose_item(const float* W, int K, int N, bf16_t* WT, int dst_row0, int k0, int n0, LAS float* scr, int lane) {
#pragma unroll 8
    for (int i = 0; i < 32; ++i) { const int kk = 2 * i + (lane >> 5); scr[kk * 33 + (lane & 31)] = W[(size_t)(k0 + kk) * N + n0 + (lane & 31)]; }
    LDS_WAIT();
    const int c = lane & 7;
#pragma unroll
    for (int j = 0; j < 4; ++j) { const int n = (lane >> 3) + 8 * j; const LAS float* s = scr + (8 * c) * 33 + n;
        u32x4 o; o.x = cvt_pk_bf16(s[0 * 33], s[1 * 33]); o.y = cvt_pk_bf16(s[2 * 33], s[3 * 33]); o.z = cvt_pk_bf16(s[4 * 33], s[5 * 33]); o.w = cvt_pk_bf16(s[6 * 33], s[7 * 33]);
        *(u32x4*)(WT + (size_t)(dst_row0 + n) * K + k0 + 8 * c) = o; }
    LDS_WAIT();
}
__device__ __forceinline__ void norm_row_bf16(const float* xrow, const float* g, bf16_t* orow, int lane) {
    f32x4 v[4]; float s = 0.f;
#pragma unroll
    for (int j = 0; j < 4; ++j) { v[j] = xrow ? ((const f32x4*)xrow)[lane + 64 * j] : (f32x4){0.f, 0.f, 0.f, 0.f}; s += (v[j].x * v[j].x + v[j].y * v[j].y) + (v[j].z * v[j].z + v[j].w * v[j].w); }
    const float rstd = rsqrtf(wave_sum(s) * (1.f / 1024.f) + EPS);
#pragma unroll
    for (int j = 0; j < 4; ++j) { const f32x4 gg = ((const f32x4*)g)[lane + 64 * j]; u32x2 o; o.x = cvt_pk_bf16(v[j].x * rstd * gg.x, v[j].y * rstd * gg.y); o.y = cvt_pk_bf16(v[j].z * rstd * gg.z, v[j].w * rstd * gg.w);
        ((u32x2*)orow)[lane + 64 * j] = o; }
}
__device__ __forceinline__ void p0_prologue(LAS unsigned char* lds, const Args& a) {
    const int tid = threadIdx.x, lane = tid & 63, wid = tid >> 6;
    LAS float* scr = (LAS float*)(lds + wid * 16384);
    const int gw = blockIdx.x * 8 + wid, NGW = gridDim.x * 8;
    unsigned char* ws = a.ws;
    for (int it = gw; it < 10240; it += NGW) {
        int r = it;
        if (r < 4352) { const int kb = r / 272, nb = r % 272; transpose_item(a.in[3], 1024, 8704, (bf16_t*)(ws + WS_WIN), 32 * nb, 64 * kb, 32 * nb, scr, lane); continue; } r -= 4352;
        if (r < 640) { const int kb = r / 32, nb = r % 32; transpose_item(a.in[13], 1280, 1024, (bf16_t*)(ws + WS_WPA), 32 * nb, 64 * kb, 32 * nb, scr, lane); continue; } r -= 640;
        if (r < 512) { const int kb = r / 32, nb = r % 32; transpose_item(a.in[14], 1024, 1024, (bf16_t*)(ws + WS_WPB), 32 * nb, 64 * kb, 32 * nb, scr, lane); continue; } r -= 512;
        if (r < 512) { const int kb = r / 32, nb = r % 32; transpose_item(a.in[15], 1024, 1024, (bf16_t*)(ws + WS_WOUT), 32 * nb, 64 * kb, 32 * nb, scr, lane); continue; } r -= 512;
        if (r < 2816) { const int kb = r / 176, nb = r % 176; const int n0 = 32 * nb; const int nn = n0 < 2816 ? n0 : n0 - 2816;
            const int dr = (nn >> 7) * 256 + (n0 < 2816 ? 0 : 128) + (nn & 127);
            transpose_item(a.in[17], 1024, 5632, (bf16_t*)(ws + WS_WFI), dr, 64 * kb, n0, scr, lane); continue; } r -= 2816;
        { const int kb = r / 32, nb = r % 32; transpose_item(a.in[18], 2816, 1024, (bf16_t*)(ws + WS_WFD), 32 * nb, 64 * kb, 32 * nb, scr, lane); }
    }
    for (int m = gw; m < MT; m += NGW) {
        const float* src = m < MX ? a.in[0] + (size_t)m * DM : (m < MX + 16 ? a.in[1] + (size_t)(m - MX) * DM : nullptr);
        norm_row_bf16(src, a.in[2], (bf16_t*)(ws + WS_XN) + (size_t)m * DM, lane);
    }
    for (int idx = blockIdx.x * 512 + tid; idx < 30720; idx += gridDim.x * 512) {
        const int l = idx & 63, f = idx >> 6, ks = f % 3, nt = (f / 3) % 5, n = (f / 15) % 16, g = f / 240, quad = l >> 4, col = l & 15;
        const float* W = (g ? a.in[8] : a.in[6]) + (size_t)n * 6400;
        float v[8];
#pragma unroll
        for (int j = 0; j < 8; ++j) { const int k = 32 * ks + 8 * quad + j; v[j] = k < 80 ? W[k * 80 + 16 * nt + col] : 0.f; }
        u32x4 o; o.x = cvt_pk_bf16(v[0], v[1]); o.y = cvt_pk_bf16(v[2], v[3]); o.z = cvt_pk_bf16(v[4], v[5]); o.w = cvt_pk_bf16(v[6], v[7]);
        ((u32x4*)(ws + WS_GFRAG))[idx] = o;
    }
}

template <int PASS>
__device__ __forceinline__ void rg_pass(LAS unsigned char* lds, const Args& a) {
    int tid_ = threadIdx.x; asm volatile("" : "+v"(tid_));
    const int tid = tid_, lane = tid & 63, wid = tid >> 6, quad = lane >> 4, col = lane & 15;
    const int g = blockIdx.x, n = g & 15, sc = (g >> 4) & 7, b = g >> 7;
    unsigned char* ws = a.ws;
    LAS u32x4* bfr = (LAS u32x4*)lds; LAS float* cw = (LAS float*)(lds + 30720); LAS float* cb = (LAS float*)(lds + 32256);
    { const u32x4* gf = (const u32x4*)(ws + WS_GFRAG);
      for (int i = tid; i < 1920; i += 512) { const int f = i >> 6, l = i & 63, gs = f / 15, r = f % 15; bfr[i] = gf[((gs * 16 + n) * 15 + r) * 64 + l]; }
      for (int i = tid; i < 384; i += 512) { const int j = i / 96, c = i % 96; cw[i] = c < 80 ? a.in[4][j * 1280 + 80 * n + c] : 0.f; }
      if (tid < 96) cb[tid] = tid < 80 ? a.in[5][80 * n + tid] : 0.f; }
    __syncthreads();
    float ba[5], bx[5], sp[5], h[5], ap[5];
#pragma unroll
    for (int nt = 0; nt < 5; ++nt) { const int c = 80 * n + 16 * nt + col; ba[nt] = a.in[7][c]; bx[nt] = a.in[9][c]; sp[nt] = 8.f * log1pf(__expf(-a.in[10][c])); h[nt] = 0.f; ap[nt] = 1.f; }
    const int c = 8 * sc + wid;
    float* agg = (float*)(ws + WS_RGAGG); float* aggm = (float*)(ws + WS_RGAGM);
    if (PASS == 2) {
#pragma unroll
        for (int nt = 0; nt < 5; ++nt) h[nt] = aggm[(n * 2 + 1) * 80 + 16 * nt + col];
        const float* ag = agg + (size_t)((b * 16 + n) * 64) * 160;
        for (int j = 0; j < c; ++j) {
#pragma unroll
            for (int nt = 0; nt < 5; ++nt) { const float A = ag[j * 160 + 16 * nt + col], U = ag[j * 160 + 80 + 16 * nt + col]; h[nt] = A * h[nt] + U; }
        }
    }
    bf16x8 idE, idO;
#pragma unroll
    for (int j = 0; j < 8; ++j) { idE[j] = (8 * quad + j == col) ? (short)0x3F80 : (short)0; idO[j] = (8 * quad + j == 16 + col) ? (short)0x3F80 : (short)0; }
    const bf16_t* AX = (const bf16_t*)(ws + WS_AX); bf16_t* AG = (bf16_t*)(ws + WS_AG);
    const int ntile = 8 + ((PASS == 1 && b == 0 && sc == 0 && wid == 0) ? 1 : 0);
    for (int it = 0; it < ntile; ++it) {
        if (PASS == 1 && it == 8) {
            if (quad == 0) {
#pragma unroll
                for (int nt = 0; nt < 5; ++nt) { agg[(size_t)((b * 16 + n) * 64 + c) * 160 + 16 * nt + col] = ap[nt]; agg[(size_t)((b * 16 + n) * 64 + c) * 160 + 80 + 16 * nt + col] = h[nt]; } }
#pragma unroll
            for (int nt = 0; nt < 5; ++nt) { h[nt] = 0.f; ap[nt] = 1.f; }
        }
        const int s0 = it < 8 ? 128 * c + 16 * it : -16;
        bf16x8 af[3];
        const int s = s0 + col;
#pragma unroll
        for (int ks = 0; ks < 3; ++ks) {
            const int ch = 32 * ks + 8 * quad;
            if (ch < 80) {
                const f32x4 b0 = *(const LAS f32x4*)(cb + ch), b1 = *(const LAS f32x4*)(cb + ch + 4);
                float xc[8] = {b0.x, b0.y, b0.z, b0.w, b1.x, b1.y, b1.z, b1.w};
#pragma unroll
                for (int j = 0; j < 4; ++j) {
                    const int r = tok_row(b, s - 3 + j);
                    if (r >= 0) {
                        const u32x4 w = *(const u32x4*)(AX + (size_t)r * RGW + 80 * n + ch);
                        const f32x4 w0 = *(const LAS f32x4*)(cw + j * 96 + ch), w1 = *(const LAS f32x4*)(cw + j * 96 + ch + 4);
                        xc[0] += w0.x * bflo(w.x); xc[1] += w0.y * bfhi(w.x); xc[2] += w0.z * bflo(w.y); xc[3] += w0.w * bfhi(w.y);
                        xc[4] += w1.x * bflo(w.z); xc[5] += w1.y * bfhi(w.z); xc[6] += w1.z * bflo(w.w); xc[7] += w1.w * bfhi(w.w);
                    }
                }
                u32x4 p; p.x = cvt_pk_bf16(xc[0], xc[1]); p.y = cvt_pk_bf16(xc[2], xc[3]); p.z = cvt_pk_bf16(xc[4], xc[5]); p.w = cvt_pk_bf16(xc[6], xc[7]);
                af[ks] = __builtin_bit_cast(bf16x8, p);
            } else af[ks] = (bf16x8){0, 0, 0, 0, 0, 0, 0, 0};
        }
#pragma unroll
        for (int nt = 0; nt < 5; ++nt) {
            f32x4 aR = {0.f, 0.f, 0.f, 0.f}, aI = {0.f, 0.f, 0.f, 0.f}, aX = {0.f, 0.f, 0.f, 0.f};
#pragma unroll
            for (int ks = 0; ks < 3; ++ks) {
                const bf16x8 bR = __builtin_bit_cast(bf16x8, bfr[(nt * 3 + ks) * 64 + lane]), bI = __builtin_bit_cast(bf16x8, bfr[((5 + nt) * 3 + ks) * 64 + lane]);
                aR = __builtin_amdgcn_mfma_f32_16x16x32_bf16(af[ks], bR, aR, 0, 0, 0);
                aI = __builtin_amdgcn_mfma_f32_16x16x32_bf16(af[ks], bI, aI, 0, 0, 0);
            }
            aX = __builtin_amdgcn_mfma_f32_16x16x32_bf16(af[nt >> 1], (nt & 1) ? idO : idE, aX, 0, 0, 0);
            float pa[4], ha[4];
#pragma unroll
            for (int r = 0; r < 4; ++r) {
                const float rr = sigm(aR[r] + ba[nt]), ii = sigm(aI[r] + bx[nt]);
                const float la = -rr * sp[nt], av = __expf(la), x2 = 2.f * la;
                const float om = x2 > -0.02f ? -x2 * (1.f + 0.5f * x2 * (1.f + x2 * (1.f / 3.f))) : 1.f - __expf(x2);
                const float uu = sqrtf(om) * ii * aX[r];
                if (r == 0) { pa[0] = av; ha[0] = uu; } else { pa[r] = pa[r - 1] * av; ha[r] = av * ha[r - 1] + uu; }
            }
            float PA = 1.f, HA = 0.f;
#pragma unroll
            for (int j = 0; j < 3; ++j) { const float pj = __shfl(pa[3], col + 16 * j), hj = __shfl(ha[3], col + 16 * j); if (j < quad) { HA = pj * HA + hj; PA = pj * PA; } }
            const float hq = PA * h[nt] + HA;
            float o[4];
#pragma unroll
            for (int r = 0; r < 4; ++r) o[r] = pa[r] * hq + ha[r];
            h[nt] = __shfl(o[3], 48 + col);
            ap[nt] *= __shfl(pa[3] * PA, 48 + col);
            if (PASS == 2) {
#pragma unroll
                for (int r = 0; r < 4; ++r) { bf16_t* p = AG + (size_t)(b * 8192 + s0 + 4 * quad + r) * RGW + 80 * n + 16 * nt + col; *p = f2bf(o[r] * bf2f(*p)); }
            }
        }
    }
    if (PASS == 1 && quad == 0) {
        float* dst = ntile == 9 ? aggm + (size_t)n * 160 : agg + (size_t)((b * 16 + n) * 64 + c) * 160;
#pragma unroll
        for (int nt = 0; nt < 5; ++nt) { dst[16 * nt + col] = ap[nt]; dst[80 + 16 * nt + col] = h[nt]; }
    }
    __syncthreads();
}

constexpr int HQE = 0, HKE = 17408, HKDT = 34816, HVT = 53248, HPB = 71680, HOB = 80896, HPART = 114688, HEM = 116736, HEB = 117248;
template <int PASS>
__device__ __forceinline__ void hg_pass(LAS unsigned char* lds, const Args& a) {
    int tid_ = threadIdx.x; asm volatile("" : "+v"(tid_));
    const int tid = tid_, lane = tid & 63, wid = tid >> 6, quad = lane >> 4, col = lane & 15;
    const int k = tid & 127, tq = tid >> 7;
    unsigned char* ws = a.ws;
    const bf16_t* Fb = (const bf16_t*)(ws + WS_F); const bf16_t* Vb = (const bf16_t*)(ws + WS_V); const bf16_t* Qb = (const bf16_t*)(ws + WS_Q);
    bf16_t* Gb = (bf16_t*)((unsigned char*)a.out + OUT_G);
    float* ST = (float*)((unsigned char*)a.out + OUT_HGS); float* STM = (float*)(ws + WS_HGSM); float* HD = (float*)(ws + WS_HGD);
    LAS float* PART = (LAS float*)(lds + HPART); LAS float* EM = (LAS float*)(lds + HEM); LAS float* EB = (LAS float*)(lds + HEB); LAS float* OB = (LAS float*)(lds + HOB);
    const int nunits = PASS == 0 ? 520 : 512;
    for (int u = blockIdx.x; u < nunits; u += gridDim.x) {
        const bool meta = u >= 512;
        const int hh = meta ? u - 512 : (u >> 5) & 7, b = meta ? 0 : u >> 8, j = u & 31, nchunk = meta ? 1 : 4;
        const float lbv = __builtin_amdgcn_rcpf(1.f + __expf(a.in[11][1024 + hh * 128 + k] - a.in[11][hh * 128 + k]));
        f32x4 S[8];
        if (PASS == 0) {
#pragma unroll
            for (int kb = 0; kb < 8; ++kb) S[kb] = (f32x4){0.f, 0.f, 0.f, 0.f};
        } else {
            const float* sp = ST + (size_t)u * 16384 + 16 * wid + col;
#pragma unroll
            for (int kb = 0; kb < 8; ++kb)
#pragma unroll
                for (int r = 0; r < 4; ++r) S[kb][r] = sp[(16 * kb + 4 * quad + r) * 128];
        }
        float btot = 0.f;
        for (int ci = 0; ci < nchunk; ++ci) {
            const int s0 = meta ? -64 : 256 * j + 64 * ci;
            float bc[16], kv[16]; unsigned short vr[16]; float qv[16];
            float csum = 0.f;
#pragma unroll
            for (int i = 0; i < 16; ++i) {
                const int r = tok_row(b, s0 + 16 * tq + i);
                if (r >= 0) {
                    float fl = bf2f(Fb[(size_t)r * DM + hh * 128 + k]); fl = fminf(fmaxf(fl, -30.f), 30.f);
                    const float e = __expf(-fl), sg = __builtin_amdgcn_rcpf(1.f + e);
                    csum += __logf(lbv + (1.f - lbv) * sg); kv[i] = (1.f - lbv) * e * sg;
                    vr[i] = Vb[(size_t)r * DM + hh * 128 + k];
                    if (PASS == 2) qv[i] = bf2f(Qb[(size_t)r * DM + hh * 128 + k]);
                } else { kv[i] = 0.f; vr[i] = 0; if (PASS == 2) qv[i] = 0.f; }
                bc[i] = csum;
            }
            PART[tq * 128 + k] = csum;
            __syncthreads();
            const float p0 = PART[k], p1 = PART[128 + k], p2 = PART[256 + k], p3 = PART[384 + k];
            const float off = tq == 0 ? 0.f : (tq == 1 ? p0 : (tq == 2 ? p0 + p1 : p0 + p1 + p2));
            const float blast = (p0 + p1) + (p2 + p3), mid = p0 + p1;
            btot += blast;
            {
                unsigned kw[8], vw[8];
#pragma unroll
                for (int i = 0; i < 8; ++i) {
                    const float e0 = __expf(blast - (off + bc[2 * i])), e1 = __expf(blast - (off + bc[2 * i + 1]));
                    kw[i] = cvt_pk_bf16(kv[2 * i] * e0, kv[2 * i + 1] * e1); vw[i] = (unsigned)vr[2 * i] | ((unsigned)vr[2 * i + 1] << 16);
                }
                LAS u32x4* kd = (LAS u32x4*)(lds + HKDT + k * 144 + tq * 32); kd[0] = (u32x4){kw[0], kw[1], kw[2], kw[3]}; kd[1] = (u32x4){kw[4], kw[5], kw[6], kw[7]};
                LAS u32x4* vt = (LAS u32x4*)(lds + HVT + k * 144 + tq * 32); vt[0] = (u32x4){vw[0], vw[1], vw[2], vw[3]}; vt[1] = (u32x4){vw[4], vw[5], vw[6], vw[7]};
            }
            if (PASS == 2) {
#pragma unroll
                for (int i = 0; i < 16; ++i) {
                    const float d = off + bc[i] - mid; const int t = 16 * tq + i;
                    *(LAS bf16_t*)(lds + HQE + t * 272 + k * 2) = f2bf(qv[i] * __expf(fminf(d, 80.f)));
                    *(LAS bf16_t*)(lds + HKE + t * 272 + k * 2) = f2bf(kv[i] * __expf(fminf(-d, 80.f)));
                }
            }
            if (tq == 0) { EB[k] = __expf(blast); EM[k] = __expf(mid); }
            __syncthreads();
            bf16x8 vf[2];
#pragma unroll
            for (int ks = 0; ks < 2; ++ks) vf[ks] = *(const LAS bf16x8*)(lds + HVT + (16 * wid + col) * 144 + ks * 64 + quad * 16);
            if (PASS == 2) {
                {
                    const int I = wid >> 1, sh = wid & 1;
                    f32x4 p0a = {0.f, 0.f, 0.f, 0.f}, p1a = {0.f, 0.f, 0.f, 0.f};
#pragma unroll
                    for (int ks = 0; ks < 4; ++ks) {
                        const bf16x8 qa = *(const LAS bf16x8*)(lds + HQE + (16 * I + col) * 272 + ks * 64 + quad * 16);
                        const bf16x8 k0 = *(const LAS bf16x8*)(lds + HKE + (32 * sh + col) * 272 + ks * 64 + quad * 16);
                        const bf16x8 k1 = *(const LAS bf16x8*)(lds + HKE + (32 * sh + 16 + col) * 272 + ks * 64 + quad * 16);
                        p0a = __builtin_amdgcn_mfma_f32_16x16x32_bf16(qa, k0, p0a, 0, 0, 0);
                        p1a = __builtin_amdgcn_mfma_f32_16x16x32_bf16(qa, k1, p1a, 0, 0, 0);
                    }
#pragma unroll
                    for (int r = 0; r < 4; ++r) { const int t = 16 * I + 4 * quad + r, sa = 32 * sh + col;
                        *(LAS bf16_t*)(lds + HPB + t * 144 + sa * 2) = sa <= t ? f2bf(p0a[r]) : (bf16_t)0;
                        *(LAS bf16_t*)(lds + HPB + t * 144 + (sa + 16) * 2) = sa + 16 <= t ? f2bf(p1a[r]) : (bf16_t)0; }
                }
                bf16x8 sf[4];
#pragma unroll
                for (int ks = 0; ks < 4; ++ks) {
                    const f32x4 ea = *(const LAS f32x4*)(EM + 32 * ks + 4 * quad), eb2 = *(const LAS f32x4*)(EM + 32 * ks + 16 + 4 * quad);
                    const f32x4 x0 = S[2 * ks] * ea, x1 = S[2 * ks + 1] * eb2;
                    u32x4 p; p.x = cvt_pk_bf16(x0.x, x0.y); p.y = cvt_pk_bf16(x0.z, x0.w); p.z = cvt_pk_bf16(x1.x, x1.y); p.w = cvt_pk_bf16(x1.z, x1.w);
                    sf[ks] = __builtin_bit_cast(bf16x8, p);
                }
                __syncthreads();
#pragma unroll
                for (int tt = 0; tt < 4; ++tt) {
                    f32x4 acc = {0.f, 0.f, 0.f, 0.f};
#pragma unroll
                    for (int ks = 0; ks < 2; ++ks) { const bf16x8 pa = *(const LAS bf16x8*)(lds + HPB + (16 * tt + col) * 144 + ks * 64 + quad * 16); acc = __builtin_amdgcn_mfma_f32_16x16x32_bf16(pa, vf[ks], acc, 0, 0, 0); }
#pragma unroll
                    for (int ks = 0; ks < 4; ++ks) {
                        const u32x2 lo = *(const LAS u32x2*)(lds + HQE + (16 * tt + col) * 272 + (32 * ks + 4 * quad) * 2), hi = *(const LAS u32x2*)(lds + HQE + (16 * tt + col) * 272 + (32 * ks + 16 + 4 * quad) * 2);
                        const u32x4 qq = {lo.x, lo.y, hi.x, hi.y};
                        acc = __builtin_amdgcn_mfma_f32_16x16x32_bf16(__builtin_bit_cast(bf16x8, qq), sf[ks], acc, 0, 0, 0);
                    }
#pragma unroll
                    for (int r = 0; r < 4; ++r) OB[(16 * tt + 4 * quad + r) * 132 + 16 * wid + col] = acc[r];
                }
            }
#pragma unroll
            for (int kb = 0; kb < 8; ++kb) {
                const f32x4 e4 = *(const LAS f32x4*)(EB + 16 * kb + 4 * quad);
                f32x4 sacc = S[kb] * e4;
#pragma unroll
                for (int ks = 0; ks < 2; ++ks) { const bf16x8 ka = *(const LAS bf16x8*)(lds + HKDT + (16 * kb + col) * 144 + ks * 64 + quad * 16); sacc = __builtin_amdgcn_mfma_f32_16x16x32_bf16(ka, vf[ks], sacc, 0, 0, 0); }
                S[kb] = sacc;
            }
            __syncthreads();
            if (PASS == 2) {
                const int t = tid >> 3, vs = (tid & 7) * 16;
                float o[16]; float ss = 0.f;
#pragma unroll
                for (int i = 0; i < 4; ++i) { const f32x4 x = *(const LAS f32x4*)(OB + t * 132 + vs + 4 * i); o[4 * i] = x.x; o[4 * i + 1] = x.y; o[4 * i + 2] = x.z; o[4 * i + 3] = x.w; ss += (x.x * x.x + x.y * x.y) + (x.z * x.z + x.w * x.w); }
                ss += __shfl_xor(ss, 1); ss += __shfl_xor(ss, 2); ss += __shfl_xor(ss, 4);
                const float rstd = rsqrtf(ss * (1.f / 128.f) + EPS);
                u32x4* gp = (u32x4*)(Gb + (size_t)(b * 8192 + s0 + t) * DM + hh * 128 + vs);
                const float* gn = a.in[12] + vs;
#pragma unroll
                for (int hf = 0; hf < 2; ++hf) {
                    const u32x4 gw = gp[hf]; u32x4 ow;
                    const unsigned gws[4] = {gw.x, gw.y, gw.z, gw.w}; unsigned ows[4];
#pragma unroll
                    for (int i = 0; i < 4; ++i) { const int e = 8 * hf + 2 * i; ows[i] = cvt_pk_bf16(o[e] * rstd * gn[e] * bflo(gws[i]), o[e + 1] * rstd * gn[e + 1] * bfhi(gws[i])); }
                    ow.x = ows[0]; ow.y = ows[1]; ow.z = ows[2]; ow.w = ows[3]; gp[hf] = ow;
                }
            }
        }
        if (PASS == 0) {
            float* sp = (meta ? STM + (size_t)hh * 16384 : ST + (size_t)u * 16384) + 16 * wid + col;
#pragma unroll
            for (int kb = 0; kb < 8; ++kb)
#pragma unroll
                for (int r = 0; r < 4; ++r) sp[(16 * kb + 4 * quad + r) * 128] = S[kb][r];
            if (!meta && tq == 0) HD[u * 128 + k] = __expf(btot);
        }
        __syncthreads();
    }
}
__device__ __forceinline__ void hg_pass_b(const Args& a) {
    float* ST = (float*)((unsigned char*)a.out + OUT_HGS); const float* STM = (const float*)(a.ws + WS_HGSM); const float* HD = (const float*)(a.ws + WS_HGD);
    for (int e = blockIdx.x * 512 + threadIdx.x; e < 16 * 16384; e += gridDim.x * 512) {
        const int bh = e >> 14, kv = e & 16383, k = kv >> 7, hh = bh & 7;
        float s = STM[hh * 16384 + kv];
#pragma unroll 8
        for (int j = 0; j < 32; ++j) { const int u = bh * 32 + j; const float d = ST[(size_t)u * 16384 + kv]; ST[(size_t)u * 16384 + kv] = s; s = HD[u * 128 + k] * s + d; }
    }
}


#ifndef RG_NAIVE
#define RG_NAIVE 0
#endif
#ifndef HG_NAIVE
#define HG_NAIVE 0
#endif
__device__ __forceinline__ void rg_naive(LAS unsigned char* lds, const Args& a) {
    if (blockIdx.x >= 32) return;
    const int b = blockIdx.x >> 4, n = blockIdx.x & 15, e = threadIdx.x, c = 80 * n + (e < 80 ? e : 0);
    LAS float* xs = (LAS float*)lds;
    const bf16_t* AX = (const bf16_t*)(a.ws + WS_AX); bf16_t* AG = (bf16_t*)(a.ws + WS_AG);
    float wa[80], wx[80];
#pragma unroll
    for (int d = 0; d < 80; ++d) { wa[d] = a.in[6][(size_t)n * 6400 + d * 80 + (e < 80 ? e : 0)]; wx[d] = a.in[8][(size_t)n * 6400 + d * 80 + (e < 80 ? e : 0)]; }
    const float ba = a.in[7][c], bx = a.in[9][c], sp = 8.f * log1pf(expf(-a.in[10][c])), cb = a.in[5][c];
    const float c0 = a.in[4][c], c1 = a.in[4][1280 + c], c2 = a.in[4][2560 + c], c3 = a.in[4][3840 + c];
    float h = 0.f, x0 = 0.f, x1 = 0.f, x2 = 0.f;
    for (int s = -16; s < 8192; ++s) {
        const float x3 = bf2f(AX[(size_t)tok_row(b, s) * RGW + c]);
        const float xc = cb + c0 * x0 + c1 * x1 + c2 * x2 + c3 * x3;
        x0 = x1; x1 = x2; x2 = x3;
        LAS float* xb = xs + (s & 1) * 80;
        if (e < 80) xb[e] = xc;
        __syncthreads();
        float r = ba, ii = bx;
#pragma unroll
        for (int d = 0; d < 80; ++d) { const float xv = xb[d]; r += xv * wa[d]; ii += xv * wx[d]; }
        const float la = -sp / (1.f + expf(-r)), av = expf(la), uu = sqrtf(-expm1f(2.f * la)) * xc / (1.f + expf(-ii));
        h = av * h + uu;
        if (s >= 0 && e < 80) { bf16_t* p = AG + (size_t)(b * 8192 + s) * RGW + c; *p = f2bf(h * bf2f(*p)); }
    }
    __syncthreads();
}
__device__ __forceinline__ void hg_naive(LAS unsigned char* lds, const Args& a) {
    if (blockIdx.x >= 16) return;
    const int b = blockIdx.x >> 3, hh = blockIdx.x & 7, v = threadIdx.x & 127; const bool act = threadIdx.x < 128;
    LAS float* fg = (LAS float*)lds; LAS float* kk = fg + 256; LAS float* qq = fg + 512; LAS float* red = fg + 768;
    const bf16_t* Fb = (const bf16_t*)(a.ws + WS_F); const bf16_t* Vb = (const bf16_t*)(a.ws + WS_V); const bf16_t* Qb = (const bf16_t*)(a.ws + WS_Q);
    bf16_t* Gb = (bf16_t*)((unsigned char*)a.out + OUT_G);
    const float lbv = 1.f / (1.f + expf(a.in[11][1024 + hh * 128 + v] - a.in[11][hh * 128 + v])), gn = a.in[12][v];
    float S[128];
#pragma unroll
    for (int k = 0; k < 128; ++k) S[k] = 0.f;
    for (int s = -16; s < 8192; ++s) {
        const int row = tok_row(b, s), par = (s & 1) * 128;
        const float fl = bf2f(Fb[(size_t)row * DM + hh * 128 + v]), sg = 1.f / (1.f + expf(-fl));
        const float vv = bf2f(Vb[(size_t)row * DM + hh * 128 + v]);
        if (act) { fg[par + v] = lbv + (1.f - lbv) * sg; kk[par + v] = (1.f - lbv) / (1.f + expf(fl)); qq[par + v] = s >= 0 ? bf2f(Qb[(size_t)row * DM + hh * 128 + v]) : 0.f; }
        __syncthreads();
        float o = 0.f;
#pragma unroll
        for (int k = 0; k < 128; ++k) { S[k] = fg[par + k] * S[k] + kk[par + k] * vv; o += S[k] * qq[par + k]; }
        const float ss = wave_sum(o * o);
        if ((threadIdx.x & 63) == 0 && act) red[(s & 1) * 2 + (threadIdx.x >> 6)] = ss;
        __syncthreads();
        if (s >= 0 && act) { const float tot = red[(s & 1) * 2] + red[(s & 1) * 2 + 1]; bf16_t* p = Gb + (size_t)(b * 8192 + s) * DM + hh * 128 + v; *p = f2bf(o * rsqrtf(tot * (1.f / 128.f) + EPS) * gn * bf2f(*p)); }
    }
    __syncthreads();
}

__device__ __forceinline__ u32x4 pack8(const f32x4& v0, const f32x4& v1) { u32x4 w; w.x = cvt_pk_bf16(v0[0], v0[1]); w.y = cvt_pk_bf16(v0[2], v0[3]); w.z = cvt_pk_bf16(v1[0], v1[1]); w.w = cvt_pk_bf16(v1[2], v1[3]); return w; }
struct EpiP1 {
    static constexpr bool PERM = true, AFTER_DRAIN = false;
    unsigned char* wsb; unsigned char* outb; int pn_off;
    __device__ __forceinline__ void operator()(const f32x4 (&acc)[2][2][4][2], const Unit& u, int wr, int wc, int fr, int fq) const {
        const int pn = u.pn + pn_off;
        const int seg = pn < 5 ? 0 : (pn < 10 ? 1 : (pn < 14 ? 2 : (pn < 18 ? 3 : (pn < 22 ? 4 : (pn < 26 ? 5 : (pn < 30 ? 6 : 7))))));
        const int ct = pn - (seg == 0 ? 0 : (seg == 1 ? 5 : (seg == 2 ? 10 : (seg == 3 ? 14 : (seg == 4 ? 18 : (seg == 5 ? 22 : (seg == 6 ? 26 : 30)))))));
        const int ld = seg < 2 ? RGW : DM, act = seg == 1 ? 1 : ((seg == 2 || seg == 5) ? 2 : (seg >= 6 ? 3 : 0));
        const size_t boff = seg == 0 ? WS_AX : (seg == 1 ? WS_AG : (seg == 2 ? WS_Q : (seg == 3 ? WS_F : (seg == 4 ? WS_V : (seg == 5 ? OUT_G : (seg == 6 ? WS_GA : WS_GB))))));
        bf16_t* base = (bf16_t*)((seg == 5 ? outb : wsb) + boff);
        if (act != 0 && u.pm >= 64) return;
        const float al = act == 1 ? 1.5957691216f : 1.f, be = act == 1 ? 0.0713548163f : 0.f;
        const int row0 = u.pm * 256 + wr * 64 + fr, col0 = ct * 256 + wc * 32 + 8 * fq;
#pragma unroll
        for (int ai = 0; ai < 2; ++ai)
#pragma unroll
            for (int m = 0; m < 4; ++m) { bf16_t* rowp = base + (size_t)(row0 + ai * 128 + m * 16) * ld + col0;
#pragma unroll
                for (int bj = 0; bj < 2; ++bj) { f32x4 v0 = acc[ai][bj][m][0], v1 = acc[ai][bj][m][1];
                    if (act) {
#pragma unroll
                        for (int i = 0; i < 4; ++i) { const float x = v0[i], y = v1[i]; const float sx = sigm(x * (al + be * x * x)), sy = sigm(y * (al + be * y * y)); v0[i] = act == 3 ? sx : x * sx; v1[i] = act == 3 ? sy : y * sy; } }
                    *(u32x4*)(rowp + bj * 128) = pack8(v0, v1); } }
    }
};
struct EpiGates {
    static constexpr bool PERM = true, AFTER_DRAIN = false;
    bf16_t *GA, *GB;
    __device__ __forceinline__ void operator()(const f32x4 (&acc)[2][2][4][2], const Unit& u, int wr, int wc, int fr, int fq) const {
        bf16_t* base = u.pn < 4 ? GA : GB; const int ct = u.pn & 3;
        const int row0 = u.pm * 256 + wr * 64 + fr, col0 = ct * 256 + wc * 32 + 8 * fq;
#pragma unroll
        for (int ai = 0; ai < 2; ++ai)
#pragma unroll
            for (int m = 0; m < 4; ++m) { bf16_t* rowp = base + (size_t)(row0 + ai * 128 + m * 16) * DM + col0;
#pragma unroll
                for (int bj = 0; bj < 2; ++bj) { f32x4 v0 = acc[ai][bj][m][0], v1 = acc[ai][bj][m][1];
#pragma unroll
                    for (int i = 0; i < 4; ++i) { v0[i] = sigm(v0[i]); v1[i] = sigm(v1[i]); }
                    *(u32x4*)(rowp + bj * 128) = pack8(v0, v1); } }
    }
};
#ifndef ZERO_A
#define ZERO_A 0
#endif
#ifndef ZERO_B
#define ZERO_B 0
#endif
template <int MODE> struct EpiMerge {
    static constexpr bool PERM = true, AFTER_DRAIN = false;
    const bf16_t* GT; const bf16_t* T1; bf16_t* O;
    __device__ __forceinline__ void operator()(const f32x4 (&acc)[2][2][4][2], const Unit& u, int wr, int wc, int fr, int fq) const {
        const int row0 = u.pm * 256 + wr * 64 + fr, col0 = u.pn * 256 + wc * 32 + 8 * fq;
#pragma unroll
        for (int ai = 0; ai < 2; ++ai)
#pragma unroll
            for (int m = 0; m < 4; ++m) { const size_t off = (size_t)(row0 + ai * 128 + m * 16) * DM + col0;
#pragma unroll
                for (int bj = 0; bj < 2; ++bj) { f32x4 v0 = acc[ai][bj][m][0], v1 = acc[ai][bj][m][1];
                    const u32x4 gw = *(const u32x4*)(GT + off + bj * 128);
                    v0[0] *= bflo(gw.x); v0[1] *= bfhi(gw.x); v0[2] *= bflo(gw.y); v0[3] *= bfhi(gw.y); v1[0] *= bflo(gw.z); v1[1] *= bfhi(gw.z); v1[2] *= bflo(gw.w); v1[3] *= bfhi(gw.w);
                    if ((MODE == 0 && ZERO_A) || (MODE == 1 && ZERO_B)) { v0 = (f32x4){0.f, 0.f, 0.f, 0.f}; v1 = v0; }
                    if (MODE == 1) { const u32x4 tw = *(const u32x4*)(T1 + off + bj * 128);
                        v0[0] += bflo(tw.x); v0[1] += bfhi(tw.x); v0[2] += bflo(tw.y); v0[3] += bfhi(tw.y); v1[0] += bflo(tw.z); v1[1] += bfhi(tw.z); v1[2] += bflo(tw.w); v1[3] += bfhi(tw.w); }
                    *(u32x4*)(O + off + bj * 128) = pack8(v0, v1); } }
    }
};
struct EpiRes {
    static constexpr bool PERM = false, AFTER_DRAIN = false;
    const float* base; float* out;
    __device__ __forceinline__ void operator()(const f32x4 (&acc)[2][2][4][2], const Unit& u, int wr, int wc, int fr, int fq) const {
        const int row0 = u.pm * 256 + wr * 64 + fr, col0 = u.pn * 256 + wc * 32 + 4 * fq;
#pragma unroll
        for (int ai = 0; ai < 2; ++ai)
#pragma unroll
            for (int m = 0; m < 4; ++m) { const size_t off = (size_t)(row0 + ai * 128 + m * 16) * DM + col0;
#pragma unroll
                for (int bj = 0; bj < 2; ++bj)
#pragma unroll
                    for (int n = 0; n < 2; ++n) { const f32x4 bs = *(const f32x4*)(base + off + bj * 128 + n * 16); *(f32x4*)(out + off + bj * 128 + n * 16) = bs + acc[ai][bj][m][n]; } }
    }
};
struct EpiFfn {
    static constexpr bool PERM = true, AFTER_DRAIN = false;
    bf16_t* O;
    __device__ __forceinline__ void operator()(const f32x4 (&acc)[2][2][4][2], const Unit& u, int wr, int wc, int fr, int fq) const {
        const int row0 = u.pm * 256 + wr * 64 + fr, col0 = u.pn * 128 + wc * 32 + 8 * fq;
#pragma unroll
        for (int ai = 0; ai < 2; ++ai)
#pragma unroll
            for (int m = 0; m < 4; ++m) { f32x4 v0, v1;
#pragma unroll
                for (int i = 0; i < 4; ++i) { const float g0 = acc[ai][0][m][0][i], g1 = acc[ai][0][m][1][i]; v0[i] = g0 * sigm(g0) * acc[ai][1][m][0][i]; v1[i] = g1 * sigm(g1) * acc[ai][1][m][1][i]; }
                *(u32x4*)(O + (size_t)(row0 + ai * 128 + m * 16) * DFF + col0) = pack8(v0, v1); }
    }
};


#ifndef SELFCHECK
#define SELFCHECK 0
#endif
constexpr size_t WS_FLAGS = 512 * 1024;
__device__ __forceinline__ unsigned hash32(unsigned x) { x ^= x >> 16; x *= 0x7feb352du; x ^= x >> 15; x *= 0x846ca68bu; x ^= x >> 16; return x; }
__device__ __forceinline__ float dot_bf_w(const bf16_t* arow, const float* W, int K, int N, int col, int lane) {
    float s = 0.f; for (int k = lane; k < K; k += 64) s += bf2f(arow[k]) * W[(size_t)k * N + col]; return wave_sum(s);
}
__device__ __forceinline__ void flag_err(unsigned char* ws, int p, float got, float ref, int lane) {
    const float e = fabsf(got - ref) / (fabsf(ref) + 0.5f);
    if (lane == 0) atomicMax((unsigned*)(ws + WS_FLAGS) + p, __float_as_uint(e != e ? 1e9f : e));
}
__device__ __forceinline__ float act_f(float x, int act) { return act == 0 ? x : (act == 1 ? 0.5f * x * (1.f + tanhf(0.7978845608f * (x + 0.044715f * x * x * x))) : x / (1.f + expf(-x))); }
template <int PH> __device__ __forceinline__ void selfcheck(const Args& a) {
    unsigned char* ws = a.ws; const int lane = threadIdx.x & 63, gw = blockIdx.x * 8 + (threadIdx.x >> 6);
    const bf16_t* XN = (const bf16_t*)(ws + WS_XN);
    for (int smp = 0; smp < 4; ++smp) {
        const unsigned hsh = hash32((unsigned)(gw * 4 + smp) * 2654435761u + PH * 977u);
        if (PH == 1) {
            const int col = hsh % N1; int row = (hsh >> 13) % (MX + (SELFCHECK == 1 ? 16 : 0));
            const int seg = col < 1280 ? 0 : (col < 2560 ? 1 : (col < 3584 ? 2 : (col < 4608 ? 3 : (col < 5632 ? 4 : 5))));
            const int act = seg == 1 ? 1 : ((seg == 2 || seg == 5) ? 2 : 0);
            if (act != 0 && row >= MX) row -= 64;
            const float ref = act_f(dot_bf_w(XN + (size_t)row * DM, a.in[3], DM, 8704, col, lane), act);
            const size_t boff = seg == 0 ? WS_AX : (seg == 1 ? WS_AG : (seg == 2 ? WS_Q : (seg == 3 ? WS_F : (seg == 4 ? WS_V : OUT_G))));
            const bf16_t* base = (const bf16_t*)((seg == 5 ? (unsigned char*)a.out : ws) + boff);
            const int ld = seg < 2 ? RGW : DM, c0 = seg == 0 ? 0 : (seg == 1 ? 1280 : (seg == 2 ? 2560 : (seg == 3 ? 3584 : (seg == 4 ? 4608 : 5632))));
            flag_err(ws, 0 + seg, bf2f(base[(size_t)row * ld + col - c0]), ref, lane);
        }
        if (PH == 2) {
            const int col = hsh % 2048, row = (hsh >> 13) % MX;
            const float ref = 1.f / (1.f + expf(-dot_bf_w(XN + (size_t)row * DM, a.in[3], DM, 8704, N1 + col, lane)));
            const bf16_t* base = col < 1024 ? (const bf16_t*)(ws + WS_GA) : (const bf16_t*)(ws + WS_GB);
            const float got = bf2f(base[(size_t)row * DM + (col & 1023)]);
            flag_err(ws, 6, got, ref, lane);
            const bf16_t* wr = (const bf16_t*)(ws + WS_WIN) + (size_t)(N1 + col) * DM; float s2 = 0.f;
            for (int k = lane; k < DM; k += 64) s2 += bf2f(XN[(size_t)row * DM + k]) * bf2f(wr[k]);
            const float ref2 = 1.f / (1.f + expf(-wave_sum(s2)));
            flag_err(ws, 16, ref2, ref, lane);
            flag_err(ws, 17, got, ref2, lane);
            if (lane == 0 && !(fabsf(got - ref) < 0.03f)) { atomicAdd((unsigned*)(ws + WS_FLAGS) + 20, 1u); if (got > 1.01f || got < -0.01f) atomicAdd((unsigned*)(ws + WS_FLAGS) + 21, 1u); }
        }
        if (PH == 3) {
            const int col = hsh % 1024, row = (hsh >> 13) % MX;
            const float pa = dot_bf_w((const bf16_t*)(ws + WS_AG) + (size_t)row * RGW, a.in[13], RGW, DM, col, lane);
            const float pb = dot_bf_w((const bf16_t*)((unsigned char*)a.out + OUT_G) + (size_t)row * DM, a.in[14], DM, DM, col, lane);
            const float ref = bf2f(((const bf16_t*)(ws + WS_GA))[(size_t)row * DM + col]) * pa + bf2f(((const bf16_t*)(ws + WS_GB))[(size_t)row * DM + col]) * pb;
            flag_err(ws, 7, bf2f(((const bf16_t*)(ws + WS_MG))[(size_t)row * DM + col]), ref, lane);
        }
        if (PH == 4) {
            const int col = hsh % 1024, row = (hsh >> 13) % MX;
            const float ref = a.in[0][(size_t)row * DM + col] + dot_bf_w((const bf16_t*)(ws + WS_MG) + (size_t)row * DM, a.in[15], DM, DM, col, lane);
            flag_err(ws, 8, a.out[(size_t)row * DM + col], ref, lane);
        }
        if (PH == 5) {
            const int col = hsh % 1024, row = (hsh >> 13) % MX; float s2 = 0.f;
            for (int k = lane; k < DM; k += 64) { const float v = a.out[(size_t)row * DM + k]; s2 += v * v; }
            const float ref = a.out[(size_t)row * DM + col] * rsqrtf(wave_sum(s2) / 1024.f + EPS) * a.in[16][col];
            flag_err(ws, 9, bf2f(XN[(size_t)row * DM + col]), ref, lane);
        }
        if (PH == 6) {
            const int col = hsh % DFF, row = (hsh >> 13) % MX;
            const float gg = dot_bf_w(XN + (size_t)row * DM, a.in[17], DM, 2 * DFF, col, lane), uu = dot_bf_w(XN + (size_t)row * DM, a.in[17], DM, 2 * DFF, DFF + col, lane);
            flag_err(ws, 10, bf2f(((const bf16_t*)(ws + WS_AG))[(size_t)row * DFF + col]), act_f(gg, 2) * uu, lane);
        }
        if (PH == 7) {
            const int col = hsh % 1024, row = (hsh >> 13) % MX;
            const float ref = a.in[0][(size_t)row * DM + col] + dot_bf_w((const bf16_t*)(ws + WS_AX) + (size_t)row * DM, a.in[15], DM, DM, col, lane)
                            + dot_bf_w((const bf16_t*)(ws + WS_AG) + (size_t)row * DFF, a.in[18], DFF, DM, col, lane);
            flag_err(ws, 11, a.out[(size_t)row * DM + col], ref, lane);
        }
    }
}

#ifndef N_LAUNCH
#define N_LAUNCH 1
#endif
__global__ void __launch_bounds__(512, 2) mega(Args a) {
    extern __shared__ __attribute__((aligned(16))) unsigned char lds_raw[];
    LAS unsigned char* lds = (LAS unsigned char*)lds_raw;
    cg::grid_group grid = cg::this_grid();
    const int lo = a.ph_lo, hi = a.ph_hi;
#define IN(k) (lo <= (k) && (k) < hi)
#define SEAM(k) do { if (IN(k) && IN((k) + 1)) { __threadfence(); grid.sync(); __threadfence(); } } while (0)
    unsigned char* ws = a.ws; const int G = gridDim.x, bid = blockIdx.x;
    bf16_t* XN = (bf16_t*)(ws + WS_XN);
    if (IN(0)) p0_prologue(lds, a);
    if (SELFCHECK && bid == 0 && threadIdx.x < 64) ((unsigned*)(ws + WS_FLAGS))[threadIdx.x] = 0u;
    SEAM(0);
    if (IN(1)) { pg8::Gemm g{XN, (const bf16_t*)(ws + WS_WIN), MT, N1, DM}; pg8::StaticOrder S; S.init(MT, N1, G, bid);
      EpiP1 E{ws, (unsigned char*)a.out, 0};
      pg8::gemm_phase<EpiP1, pg8::StaticOrder, true, true>(lds, g, S, E); }
    SEAM(1);
    if (SELFCHECK) { selfcheck<1>(a); __threadfence(); grid.sync(); __threadfence(); }
    if (IN(2)) { if (!RG_NAIVE) rg_pass<1>(lds, a); if (!HG_NAIVE) hg_pass<0>(lds, a); }
    SEAM(2);
    if (IN(3)) { if (!HG_NAIVE) hg_pass_b(a); }
    SEAM(3);
    if (IN(4)) { if (RG_NAIVE) rg_naive(lds, a); else rg_pass<2>(lds, a);
                 if (HG_NAIVE) hg_naive(lds, a); else hg_pass<2>(lds, a); }
    SEAM(4);
    if (IN(5)) { pg8::Gemm g{XN, (const bf16_t*)(ws + WS_WIN) + (size_t)N1 * DM, MX, 2048, DM}; pg8::StaticOrder S; S.init(MX, 2048, G, bid);
      EpiP1 E{ws, (unsigned char*)a.out, 26};
      pg8::gemm_phase<EpiP1, pg8::StaticOrder, true, true>(lds, g, S, E); }
    SEAM(5);
    if (SELFCHECK) { selfcheck<2>(a); __threadfence(); grid.sync(); __threadfence(); }
    if (IN(6)) { pg8::StaticOrder S; S.init(MX, DM, G, bid);
      { pg8::Gemm g{(const bf16_t*)(ws + WS_AG), (const bf16_t*)(ws + WS_WPA), MX, DM, RGW};
        EpiMerge<0> E{(const bf16_t*)(ws + WS_GA), nullptr, (bf16_t*)(ws + WS_T1)};
        pg8::gemm_phase<EpiMerge<0>, pg8::StaticOrder, false, true>(lds, g, S, E); }
      __syncthreads();
      { pg8::Gemm g{(const bf16_t*)((unsigned char*)a.out + OUT_G), (const bf16_t*)(ws + WS_WPB), MX, DM, DM};
        EpiMerge<1> E{(const bf16_t*)(ws + WS_GB), (const bf16_t*)(ws + WS_T1), (bf16_t*)(ws + WS_MG)};
        pg8::gemm_phase<EpiMerge<1>, pg8::StaticOrder, false, true>(lds, g, S, E); } }
    SEAM(6);
    if (SELFCHECK) { selfcheck<3>(a); __threadfence(); grid.sync(); __threadfence(); }
    if (IN(7)) { pg8::Gemm g{(const bf16_t*)(ws + WS_MG), (const bf16_t*)(ws + WS_WOUT), MX, DM, DM}; pg8::StaticOrder S; S.init(MX, DM, G, bid);
      EpiRes E{a.in[0], a.out};
      pg8::gemm_phase<EpiRes, pg8::StaticOrder, false, true>(lds, g, S, E); }
    SEAM(7);
    if (SELFCHECK) { selfcheck<4>(a); __threadfence(); grid.sync(); __threadfence(); }
    if (IN(8)) { for (int m = bid * 8 + __builtin_amdgcn_readfirstlane(threadIdx.x >> 6); m < MX; m += G * 8) norm_row_bf16(a.out + (size_t)m * DM, a.in[16], XN + (size_t)m * DM, (int)__lane_id()); }
    SEAM(8);
    if (SELFCHECK) { selfcheck<5>(a); __threadfence(); grid.sync(); __threadfence(); }
    if (IN(9)) { pg8::Gemm g{XN, (const bf16_t*)(ws + WS_WFI), MX, 2 * DFF, DM}; pg8::StaticOrder S; S.init(MX, 2 * DFF, G, bid);
      EpiFfn E{(bf16_t*)(ws + WS_AG)};
      pg8::gemm_phase<EpiFfn, pg8::StaticOrder, true, true>(lds, g, S, E); }
    SEAM(9);
    if (SELFCHECK) { selfcheck<6>(a); __threadfence(); grid.sync(); __threadfence(); }
    if (IN(10)) { pg8::Gemm g{(const bf16_t*)(ws + WS_AG), (const bf16_t*)(ws + WS_WFD), MX, DM, DFF}; pg8::StaticOrder S; S.init(MX, DM, G, bid);
      EpiRes E{a.out, a.out};
      pg8::gemm_phase<EpiRes, pg8::StaticOrder, false, true>(lds, g, S, E); }
    SEAM(10);
    if (SELFCHECK) { selfcheck<7>(a); __threadfence(); grid.sync(); __threadfence(); }
    if (IN(11)) { for (int m = bid * 8 + __builtin_amdgcn_readfirstlane(threadIdx.x >> 6); m < MX; m += G * 8) {
        const int lane = (int)__lane_id();
        float* row = a.out + (size_t)m * DM; f32x4 v[4]; float s = 0.f;
#pragma unroll
        for (int j = 0; j < 4; ++j) { v[j] = ((const f32x4*)row)[lane + 64 * j]; s += (v[j].x * v[j].x + v[j].y * v[j].y) + (v[j].z * v[j].z + v[j].w * v[j].w); }
        const float rstd = rsqrtf(wave_sum(s) * (1.f / 1024.f) + EPS);
#pragma unroll
        for (int j = 0; j < 4; ++j) { const f32x4 gg = ((const f32x4*)a.in[19])[lane + 64 * j]; ((f32x4*)row)[lane + 64 * j] = v[j] * rstd * gg; }
    } }
    if (SELFCHECK) { __threadfence(); grid.sync(); __threadfence(); if (bid == 0 && threadIdx.x == 0) { const unsigned* fl = (const unsigned*)(ws + WS_FLAGS);
        const int mask = (__uint_as_float(fl[6]) > 0.05f ? 1 : 0) + (__uint_as_float(fl[16]) > 0.05f ? 2 : 0) + (__uint_as_float(fl[17]) > 0.05f ? 4 : 0) + (fl[21] > 0 ? 8 : 0);
        const int kk = 1 + (int)fl[20]; for (int i = 0; i < kk; ++i) a.out[i] = 1000.f * (1 + mask); } }
}

extern "C" void kernel_launch(void* const* d_in, const int* in_sizes, int n_in, void* d_out, int out_size, void* d_ws, size_t ws_size, hipStream_t stream) {
    static int ok = 0;
    if (!ok) { (void)hipFuncSetAttribute((const void*)mega, hipFuncAttributeMaxDynamicSharedMemorySize, LDS_BYTES); ok = 1; }
    Args a{};
    for (int i = 0; i < 20; ++i) a.in[i] = (const float*)d_in[i];
    a.out = (float*)d_out; a.ws = (unsigned char*)d_ws;
    if (N_LAUNCH == 1) {
        a.ph_lo = 0; a.ph_hi = 12;
        void* args[] = {&a};
        hipError_t e = hipLaunchCooperativeKernel((const void*)mega, dim3(256), dim3(512), args, LDS_BYTES, stream);
        if (e != hipSuccess) fprintf(stderr, "cooperative launch failed: %s\n", hipGetErrorString(e));
    } else {
        for (int k = 0; k < 12; ++k) { a.ph_lo = k; a.ph_hi = k + 1; hipLaunchKernelGGL(mega, dim3(256), dim3(512), LDS_BYTES, stream, a); }
    }
}
```

```cpp
#include <hip/hip_runtime.h>
#include <hip/hip_cooperative_groups.h>
#include <cstdio>
#include <cstdint>
namespace cg = cooperative_groups;
namespace pg8 {
#define PG8_LAS __attribute__((address_space(3)))
typedef unsigned short bf16_t;
typedef short bf16x8 __attribute__((ext_vector_type(8)));
typedef float f32x4 __attribute__((ext_vector_type(4)));
typedef unsigned u32x4 __attribute__((ext_vector_type(4)));
constexpr int BM = 256, BK = 64, HALF = 128, HTB = HALF * BK * 2  , STAGE_BYTES = 8 * HTB, NXCD = 8, WGM = 8;

__host__ __device__ __forceinline__ int lds_byte(int r, int c) { const int st = (r >> 4) * 2 + (c >> 5), rr = r & 15, cc = c & 31, ob = rr * 64 + cc * 2; return st * 1024 + (ob ^ (((ob >> 9) & 1) << 5)); }
__host__ __device__ __forceinline__ void stage_rc(int b, int& R, int& C) { const int st = b / 1024, sb = b % 1024, swz = sb ^ (((sb >> 9) & 1) << 5); R = (st >> 1) * 16 + swz / 64; C = (st & 1) * 32 + (swz % 64) / 2; }
__host__ __device__ __forceinline__ int perm32(int rho) { const int n = rho >> 4, i = rho & 15; return 8 * (i >> 2) + 4 * n + (i & 3); }

struct Unit { int pm, pn; };
struct Gemm { const bf16_t* A; const bf16_t* Bt; int M, N, K; };

struct StaticOrder {
    int nM, nN, nwg, G, c;
    __host__ __device__ void init(int M, int N, int G_, int c_) { nM = M / BM; nN = N / BM; nwg = nM * nN; G = G_; c = c_; }
    __host__ __device__ bool next(int i, Unit& u) const {
        const long L = (long)i * G + c; if (L >= nwg) return false;
        int wgid = (int)L; { const int q = nwg / NXCD, r = nwg % NXCD, xcd = wgid % NXCD, off = wgid / NXCD; wgid = (xcd < r ? xcd * (q + 1) : r * (q + 1) + (xcd - r) * q) + off; }
        const int nig = WGM * nN, gid = wgid / nig, fm = gid * WGM, gsz = (nM - fm) < WGM ? (nM - fm) : WGM;
        u.pm = fm + ((wgid % nig) % gsz); u.pn = (wgid % nig) / gsz; return true;
    }
    __device__ __forceinline__ void a_ready(const Unit&) const {}
    __device__ __forceinline__ void done(const Unit&) const {}
};
__device__ __forceinline__ unsigned cvt_pk_bf16(float lo, float hi) { unsigned r; asm volatile("v_cvt_pk_bf16_f32 %0, %1, %2" : "=v"(r) : "v"(lo), "v"(hi)); return r; }
template <class Epi, class Sched, bool ALIGN_EPI = false, bool SP2 = false>
__device__ __forceinline__ void gemm_phase(PG8_LAS unsigned char* lds, const Gemm g, const Sched& S, const Epi& E) {
    int tid_ = threadIdx.x; asm volatile("" : "+v"(tid_));
    const int tid = tid_, wid = __builtin_amdgcn_readfirstlane(tid >> 6), lane = tid & 63, wr = wid >> 2, wc = wid & 3, fr = lane & 15, fq = lane >> 4;
    const int K = g.K, nt = K / BK;
    unsigned voffA[2], voffB[2];
#pragma unroll
    for (int i = 0; i < 2; ++i) { int R, C; stage_rc(tid * 16 + i * 8192, R, C); const int Rb = Epi::PERM ? ((R & ~31) + perm32(R & 31)) : R;
        voffA[i] = (unsigned)(R * K + C) * 2u; voffB[i] = (unsigned)(Rb * K + C) * 2u; }
    const size_t kstep = (size_t)(BK * 2);
    const size_t hstep = (size_t)HALF * K * 2;
    const size_t tstep = 2 * hstep;
    const unsigned ldsw = (unsigned)wid * 1024u;
    const int aoff = lds_byte(wr * 64 + fr, fq * 8), boff = lds_byte(wc * 32 + fr, fq * 8);
#define PG8_SA(b, h) (((b) * 2 + (h)) * HTB)
#define PG8_SB(b, h) ((4 + (b) * 2 + (h)) * HTB)
#define PG8_STAGE(bufoff, gbase, voff) do { _Pragma("unroll") for (int _i = 0; _i < 2; ++_i) \
        __builtin_amdgcn_global_load_lds((const unsigned*)((const char*)(gbase) + (voff)[_i]), (PG8_LAS unsigned*)(lds + (bufoff) + ldsw + _i * 8192), 16, 0, 0); } while (0)
#define PG8_LDA(dst, b, h) do { _Pragma("unroll") for (int m = 0; m < 4; ++m) _Pragma("unroll") for (int k = 0; k < 2; ++k) dst[m][k] = *(const PG8_LAS bf16x8*)(lds + PG8_SA(b, h) + aoff + m * 2048 + k * 1024); } while (0)
#define PG8_LDB(dst, b, h) do { _Pragma("unroll") for (int n = 0; n < 2; ++n) _Pragma("unroll") for (int k = 0; k < 2; ++k) dst[n][k] = *(const PG8_LAS bf16x8*)(lds + PG8_SB(b, h) + boff + n * 2048 + k * 1024); } while (0)
#define PG8_MMA(ai, bj, At, Bt) do { __builtin_amdgcn_s_setprio(1); _Pragma("unroll") for (int m = 0; m < 4; ++m) _Pragma("unroll") for (int n = 0; n < 2; ++n) _Pragma("unroll") for (int k = 0; k < 2; ++k) \
        acc[ai][bj][m][n] = __builtin_amdgcn_mfma_f32_16x16x32_bf16(Bt[n][k], At[m][k], acc[ai][bj][m][n], 0, 0, 0); __builtin_amdgcn_s_setprio(0); } while (0)
#define PG8_WAIT_V(n) asm volatile("s_waitcnt vmcnt(" #n ")" ::: "memory")
#define PG8_WAIT_L(n) asm volatile("s_waitcnt lgkmcnt(" #n ")" ::: "memory")
#define PG8_BAR __builtin_amdgcn_s_barrier()
#define PG8_SCHED __builtin_amdgcn_sched_barrier(0)
    Unit cur, nxt; int ui = 0;
    if (!S.next(0, cur)) return;
    f32x4 acc[2][2][4][2];
#pragma unroll
    for (int a = 0; a < 2; ++a)
#pragma unroll
        for (int b = 0; b < 2; ++b)
#pragma unroll
            for (int m = 0; m < 4; ++m)
#pragma unroll
                for (int n = 0; n < 2; ++n) acc[a][b][m][n] = (f32x4){0.f, 0.f, 0.f, 0.f};
    bf16x8 At[4][2], B0[2][2], B1[2][2];
    const char* cA = (const char*)g.A + (size_t)cur.pm * tstep; const char* cB = (const char*)g.Bt + (size_t)cur.pn * tstep;
    S.a_ready(cur);
    if constexpr (SP2) {
        PG8_STAGE(PG8_SB(0, 0), cB, voffB); PG8_STAGE(PG8_SB(0, 1), cB + hstep, voffB); PG8_STAGE(PG8_SA(0, 0), cA, voffA); PG8_STAGE(PG8_SA(0, 1), cA + hstep, voffA);
        if (wr == 1) PG8_BAR;
        PG8_WAIT_V(2); PG8_BAR;
        PG8_STAGE(PG8_SB(1, 0), cB + kstep, voffB); PG8_STAGE(PG8_SA(1, 0), cA + kstep, voffA); PG8_STAGE(PG8_SB(1, 1), cB + hstep + kstep, voffB);
        PG8_WAIT_V(6); PG8_BAR;
    } else {
        PG8_STAGE(PG8_SB(0, 0), cB, voffB); PG8_STAGE(PG8_SA(0, 0), cA, voffA); PG8_STAGE(PG8_SB(0, 1), cB + hstep, voffB); PG8_STAGE(PG8_SA(0, 1), cA + hstep, voffA);
        if (wr == 1) PG8_BAR;
        PG8_WAIT_V(4); PG8_BAR;
        PG8_STAGE(PG8_SB(1, 0), cB + kstep, voffB); PG8_STAGE(PG8_SA(1, 0), cA + kstep, voffA); PG8_STAGE(PG8_SB(1, 1), cB + hstep + kstep, voffB);
        PG8_WAIT_V(6); PG8_BAR;
    }
    for (;;) {
        const bool has_next = S.next(ui + 1, nxt);
        const char* nA = has_next ? (const char*)g.A + (size_t)nxt.pm * tstep : cA; const char* nB = has_next ? (const char*)g.Bt + (size_t)nxt.pn * tstep : cB;
        for (int t = 0; t < nt; t += 2) {
            const bool last = (t == nt - 2);
            const char* a1 = cA + (size_t)(t + 1) * kstep;
            const char* a2 = last ? nA : cA + (size_t)(t + 2) * kstep; const char* b2 = last ? nB : cB + (size_t)(t + 2) * kstep;
            const char* a3 = a2 + kstep; const char* b3 = b2 + kstep;
            if (last && has_next) S.a_ready(nxt);
            if constexpr (SP2) {
            PG8_LDB(B0, 0, 0); PG8_LDB(B1, 0, 1); PG8_SCHED; PG8_LDA(At, 0, 0); PG8_STAGE(PG8_SA(1, 1), a1 + hstep, voffA);
            PG8_WAIT_V(8); PG8_WAIT_L(0); PG8_BAR; PG8_MMA(0, 0, At, B0); PG8_MMA(0, 1, At, B1); PG8_BAR; PG8_SCHED;
            PG8_LDA(At, 0, 1); PG8_STAGE(PG8_SB(0, 0), b2, voffB); PG8_STAGE(PG8_SB(0, 1), b2 + hstep, voffB); PG8_STAGE(PG8_SA(0, 0), a2, voffA);
            PG8_WAIT_V(8); PG8_WAIT_L(0); PG8_BAR; PG8_MMA(1, 0, At, B0); PG8_MMA(1, 1, At, B1); PG8_BAR; PG8_SCHED;
            PG8_LDB(B0, 1, 0); PG8_LDB(B1, 1, 1); PG8_SCHED; PG8_LDA(At, 1, 0); PG8_STAGE(PG8_SA(0, 1), a2 + hstep, voffA);
            PG8_WAIT_V(8); PG8_WAIT_L(0); PG8_BAR; PG8_MMA(0, 0, At, B0); PG8_MMA(0, 1, At, B1); PG8_BAR; PG8_SCHED;
            PG8_LDA(At, 1, 1); PG8_STAGE(PG8_SB(1, 0), b3, voffB); PG8_STAGE(PG8_SB(1, 1), b3 + hstep, voffB); PG8_STAGE(PG8_SA(1, 0), a3, voffA);
            PG8_WAIT_V(8); PG8_WAIT_L(0); PG8_BAR; PG8_MMA(1, 0, At, B0); PG8_MMA(1, 1, At, B1); PG8_BAR; PG8_SCHED;
            } else {
            PG8_LDB(B0, 0, 0); PG8_SCHED; PG8_LDA(At, 0, 0); PG8_STAGE(PG8_SA(1, 1), a1 + hstep, voffA);
            PG8_WAIT_L(8); PG8_BAR; PG8_WAIT_L(0); PG8_MMA(0, 0, At, B0); PG8_BAR; PG8_SCHED;
            PG8_LDB(B1, 0, 1); PG8_STAGE(PG8_SB(0, 0), b2, voffB);
            PG8_BAR; PG8_WAIT_L(0); PG8_MMA(0, 1, At, B1); PG8_BAR;
            PG8_LDA(At, 0, 1); PG8_STAGE(PG8_SA(0, 0), a2, voffA);
            PG8_BAR; PG8_WAIT_L(0); PG8_MMA(1, 0, At, B0); PG8_BAR; PG8_SCHED;
            PG8_STAGE(PG8_SB(0, 1), b2 + hstep, voffB);
            PG8_WAIT_V(6); PG8_BAR; PG8_MMA(1, 1, At, B1); PG8_BAR;
            PG8_LDB(B0, 1, 0); PG8_SCHED; PG8_LDA(At, 1, 0); PG8_STAGE(PG8_SA(0, 1), a2 + hstep, voffA);
            PG8_WAIT_L(8); PG8_BAR; PG8_WAIT_L(0); PG8_MMA(0, 0, At, B0); PG8_BAR; PG8_SCHED;
            PG8_LDB(B1, 1, 1); PG8_STAGE(PG8_SB(1, 0), b3, voffB);
            PG8_BAR; PG8_WAIT_L(0); PG8_MMA(0, 1, At, B1); PG8_BAR;
            PG8_LDA(At, 1, 1); PG8_STAGE(PG8_SA(1, 0), a3, voffA);
            PG8_BAR; PG8_WAIT_L(0); PG8_MMA(1, 0, At, B0); PG8_BAR; PG8_SCHED;
            PG8_STAGE(PG8_SB(1, 1), b3 + hstep, voffB);
            PG8_WAIT_V(6); PG8_BAR; PG8_MMA(1, 1, At, B1); PG8_BAR;
            }
        }
        if constexpr (ALIGN_EPI) { if (wr == 0) PG8_BAR; }
        if constexpr (!Epi::AFTER_DRAIN) { E(acc, cur, wr, wc, fr, fq); S.done(cur); }
        if (!has_next) break;
#pragma unroll
        for (int a = 0; a < 2; ++a)
#pragma unroll
            for (int b = 0; b < 2; ++b)
#pragma unroll
                for (int m = 0; m < 4; ++m)
#pragma unroll
                    for (int n = 0; n < 2; ++n) acc[a][b][m][n] = (f32x4){0.f, 0.f, 0.f, 0.f};
        cur = nxt; cA = nA; cB = nB; ++ui;
        if constexpr (ALIGN_EPI) { if (wr == 1) PG8_BAR; }
    }
    PG8_WAIT_V(0);
    if constexpr (!ALIGN_EPI) { if (wr == 0) PG8_BAR; }
    PG8_BAR;
    if constexpr (Epi::AFTER_DRAIN) { E.fused(acc, cur, wr, wc, fr, fq, lds, wid, lane); S.done(cur); }
#undef PG8_SA
#undef PG8_SB
#undef PG8_STAGE
#undef PG8_LDA
#undef PG8_LDB
#undef PG8_MMA
#undef PG8_WAIT_V
#undef PG8_WAIT_L
#undef PG8_BAR
#undef PG8_SCHED
}
}
using pg8::bf16_t; using pg8::bf16x8; using pg8::f32x4; using pg8::u32x4; using pg8::Unit; using pg8::cvt_pk_bf16;
#define LAS __attribute__((address_space(3)))
typedef unsigned u32x2 __attribute__((ext_vector_type(2)));

constexpr int MX = 16384, MT = 16640, DM = 1024, RGW = 1280, DFF = 2816, N1 = 6656;
constexpr float EPS = 1e-6f;
constexpr size_t MiB = (size_t)1 << 20;
constexpr size_t WS_WIN = 1 * MiB;
constexpr size_t WS_WPA = 18 * MiB;
constexpr size_t WS_WPB = WS_WPA + 2621440;
constexpr size_t WS_WOUT = WS_WPB + 2 * MiB;
constexpr size_t WS_WFI = WS_WOUT + 2 * MiB;
constexpr size_t WS_WFD = WS_WFI + 11 * MiB;
constexpr size_t WS_MISC = 41 * MiB;
constexpr size_t WS_GFRAG = WS_MISC;
constexpr size_t WS_RGAGG = WS_MISC + 512 * 1024;
constexpr size_t WS_RGAGM = WS_MISC + 1792 * 1024;
constexpr size_t WS_HGD = WS_MISC + 1856 * 1024;
constexpr size_t WS_HGSM = WS_MISC + 2112 * 1024;
constexpr size_t WS_XN = 44 * MiB;
constexpr size_t WS_AX = WS_XN + (size_t)MT * DM * 2;
constexpr size_t WS_AG = WS_AX + (size_t)MT * RGW * 2;
constexpr size_t WS_Q = WS_AG + (size_t)MX * RGW * 2;
constexpr size_t WS_F = WS_Q + (size_t)MX * DM * 2;
constexpr size_t WS_V = WS_F + (size_t)MT * DM * 2;
static_assert(WS_V + (size_t)MT * DM * 2 <= 256 * MiB, "ws map");
static_assert(WS_AG + (size_t)MX * DFF * 2 <= WS_V, "ACT overlay");
constexpr size_t WS_GA = WS_AX, WS_GB = WS_V, WS_T1 = WS_Q, WS_MG = WS_F;
constexpr size_t OUT_G = 0, OUT_HGS = 32 * MiB;
constexpr int LDS_BYTES = 147456;

struct Args { const float* in[20]; float* out; unsigned char* ws; int ph_lo, ph_hi; };

__device__ __forceinline__ float bf2f(unsigned short b) { return __uint_as_float(((unsigned)b) << 16); }
__device__ __forceinline__ float bflo(unsigned w) { return __uint_as_float(w << 16); }
__device__ __forceinline__ float bfhi(unsigned w) { return __uint_as_float(w & 0xffff0000u); }
__device__ __forceinline__ unsigned short f2bf(float f) { unsigned u = __float_as_uint(f); return (unsigned short)((u + 0x7fffu + ((u >> 16) & 1u)) >> 16); }
__device__ __forceinline__ float sigm(float x) { return __builtin_amdgcn_rcpf(1.f + __expf(-x)); }
__device__ __forceinline__ float wave_sum(float v) {
#pragma unroll
    for (int o = 1; o < 64; o <<= 1) v += __shfl_xor(v, o);
    return v;
}
#define LDS_WAIT() asm volatile("s_waitcnt lgkmcnt(0)" ::: "memory")
__device__ __forceinline__ int tok_row(int b, int s) { return s >= 0 ? b * 8192 + s : (s >= -16 ? 16400 + s : -1); }

__device__ __forceinline__ void transpose_item(const float* W, int K, int N, bf16_t* WT, int dst_row0, int k0, int n0, LAS float* scr, int lane) {
#pragma unroll 8
    for (int i = 0; i < 32; ++i) { const int kk = 2 * i + (lane >> 5); scr[kk * 33 + (lane & 31)] = W[(size_t)(k0 + kk) * N + n0 + (lane & 31)]; }
    LDS_WAIT();
    const int c = lane & 7;
#pragma unroll
    for (int j = 0; j < 4; ++j) { const int n = (lane >> 3) + 8 * j; const LAS float* s = scr + (8 * c) * 33 + n;
        u32x4 o; o.x = cvt_pk_bf16(s[0 * 33], s[1 * 33]); o.y = cvt_pk_bf16(s[2 * 33], s[3 * 33]); o.z = cvt_pk_bf16(s[4 * 33], s[5 * 33]); o.w = cvt_pk_bf16(s[6 * 33], s[7 * 33]);
        *(u32x4*)(WT + (size_t)(dst_row0 + n) * K + k0 + 8 * c) = o; }
    LDS_WAIT();
}
__device__ __forceinline__ void norm_row_bf16(const float* xrow, const float* g, bf16_t* orow, int lane) {
    f32x4 v[4]; float s = 0.f;
#pragma unroll
    for (int j = 0; j < 4; ++j) { v[j] = xrow ? ((const f32x4*)xrow)[lane + 64 * j] : (f32x4){0.f, 0.f, 0.f, 0.f}; s += (v[j].x * v[j].x + v[j].y * v[j].y) + (v[j].z * v[j].z + v[j].w * v[j].w); }
    const float rstd = rsqrtf(wave_sum(s) * (1.f / 1024.f) + EPS);
#pragma unroll
    for (int j = 0; j < 4; ++j) { const f32x4 gg = ((const f32x4*)g)[lane + 64 * j]; u32x2 o; o.x = cvt_pk_bf16(v[j].x * rstd * gg.x, v[j].y * rstd * gg.y); o.y = cvt_pk_bf16(v[j].z * rstd * gg.z, v[j].w * rstd * gg.w);
        ((u32x2*)orow)[lane + 64 * j] = o; }
}
__device__ __forceinline__ void p0_prologue(LAS unsigned char* lds, const Args& a) {
    const int tid = threadIdx.x, lane = tid & 63, wid = tid >> 6;
    LAS float* scr = (LAS float*)(lds + wid * 16384);
    const int gw = blockIdx.x * 8 + wid, NGW = gridDim.x * 8;
    unsigned char* ws = a.ws;
    for (int it = gw; it < 10240; it += NGW) {
        int r = it;
        if (r < 4352) { const int kb = r / 272, nb = r % 272; transpose_item(a.in[3], 1024, 8704, (bf16_t*)(ws + WS_WIN), 32 * nb, 64 * kb, 32 * nb, scr, lane); continue; } r -= 4352;
        if (r < 640) { const int kb = r / 32, nb = r % 32; transpose_item(a.in[13], 1280, 1024, (bf16_t*)(ws + WS_WPA), 32 * nb, 64 * kb, 32 * nb, scr, lane); continue; } r -= 640;
        if (r < 512) { const int kb = r / 32, nb = r % 32; transpose_item(a.in[14], 1024, 1024, (bf16_t*)(ws + WS_WPB), 32 * nb, 64 * kb, 32 * nb, scr, lane); continue; } r -= 512;
        if (r < 512) { const int kb = r / 32, nb = r % 32; transpose_item(a.in[15], 1024, 1024, (bf16_t*)(ws + WS_WOUT), 32 * nb, 64 * kb, 32 * nb, scr, lane); continue; } r -= 512;
        if (r < 2816) { const int kb = r / 176, nb = r % 176; const int n0 = 32 * nb; const int nn = n0 < 2816 ? n0 : n0 - 2816;
            const int dr = (nn >> 7) * 256 + (n0 < 2816 ? 0 : 128) + (nn & 127);
            transpose_item(a.in[17], 1024, 5632, (bf16_t*)(ws + WS_WFI), dr, 64 * kb, n0, scr, lane); continue; } r -= 2816;
        { const int kb = r / 32, nb = r % 32; transpose_item(a.in[18], 2816, 1024, (bf16_t*)(ws + WS_WFD), 32 * nb, 64 * kb, 32 * nb, scr, lane); }
    }
    for (int m = gw; m < MT; m += NGW) {
        const float* src = m < MX ? a.in[0] + (size_t)m * DM : (m < MX + 16 ? a.in[1] + (size_t)(m - MX) * DM : nullptr);
        norm_row_bf16(src, a.in[2], (bf16_t*)(ws + WS_XN) + (size_t)m * DM, lane);
    }
    for (int idx = blockIdx.x * 512 + tid; idx < 30720; idx += gridDim.x * 512) {
        const int l = idx & 63, f = idx >> 6, ks = f % 3, nt = (f / 3) % 5, n = (f / 15) % 16, g = f / 240, quad = l >> 4, col = l & 15;
        const float* W = (g ? a.in[8] : a.in[6]) + (size_t)n * 6400;
        float v[8];
#pragma unroll
        for (int j = 0; j < 8; ++j) { const int k = 32 * ks + 8 * quad + j; v[j] = k < 80 ? W[k * 80 + 16 * nt + col] : 0.f; }
        u32x4 o; o.x = cvt_pk_bf16(v[0], v[1]); o.y = cvt_pk_bf16(v[2], v[3]); o.z = cvt_pk_bf16(v[4], v[5]); o.w = cvt_pk_bf16(v[6], v[7]);
        ((u32x4*)(ws + WS_GFRAG))[idx] = o;
    }
}

template <int PASS>
__device__ __forceinline__ void rg_pass(LAS unsigned char* lds, const Args& a) {
    int tid_ = threadIdx.x; asm volatile("" : "+v"(tid_));
    const int tid = tid_, lane = tid & 63, wid = tid >> 6, quad = lane >> 4, col = lane & 15;
    const int g = blockIdx.x, n = g & 15, sc = (g >> 4) & 7, b = g >> 7;
    unsigned char* ws = a.ws;
    LAS u32x4* bfr = (LAS u32x4*)lds; LAS float* cw = (LAS float*)(lds + 30720); LAS float* cb = (LAS float*)(lds + 32256);
    { const u32x4* gf = (const u32x4*)(ws + WS_GFRAG);
      for (int i = tid; i < 1920; i += 512) { const int f = i >> 6, l = i & 63, gs = f / 15, r = f % 15; bfr[i] = gf[((gs * 16 + n) * 15 + r) * 64 + l]; }
      for (int i = tid; i < 384; i += 512) { const int j = i / 96, c = i % 96; cw[i] = c < 80 ? a.in[4][j * 1280 + 80 * n + c] : 0.f; }
      if (tid < 96) cb[tid] = tid < 80 ? a.in[5][80 * n + tid] : 0.f; }
    __syncthreads();
    float ba[5], bx[5], sp[5], h[5], ap[5];
#pragma unroll
    for (int nt = 0; nt < 5; ++nt) { const int c = 80 * n + 16 * nt + col; ba[nt] = a.in[7][c]; bx[nt] = a.in[9][c]; sp[nt] = 8.f * log1pf(__expf(-a.in[10][c])); h[nt] = 0.f; ap[nt] = 1.f; }
    const int c = 8 * sc + wid;
    float* agg = (float*)(ws + WS_RGAGG); float* aggm = (float*)(ws + WS_RGAGM);
    if (PASS == 2) {
#pragma unroll
        for (int nt = 0; nt < 5; ++nt) h[nt] = aggm[(n * 2 + 1) * 80 + 16 * nt + col];
        const float* ag = agg + (size_t)((b * 16 + n) * 64) * 160;
        for (int j = 0; j < c; ++j) {
#pragma unroll
            for (int nt = 0; nt < 5; ++nt) { const float A = ag[j * 160 + 16 * nt + col], U = ag[j * 160 + 80 + 16 * nt + col]; h[nt] = A * h[nt] + U; }
        }
    }
    bf16x8 idE, idO;
#pragma unroll
    for (int j = 0; j < 8; ++j) { idE[j] = (8 * quad + j == col) ? (short)0x3F80 : (short)0; idO[j] = (8 * quad + j == 16 + col) ? (short)0x3F80 : (short)0; }
    const bf16_t* AX = (const bf16_t*)(ws + WS_AX); bf16_t* AG = (bf16_t*)(ws + WS_AG);
    const int ntile = 8 + ((PASS == 1 && b == 0 && sc == 0 && wid == 0) ? 1 : 0);
    for (int it = 0; it < ntile; ++it) {
        if (PASS == 1 && it == 8) {
            if (quad == 0) {
#pragma unroll
                for (int nt = 0; nt < 5; ++nt) { agg[(size_t)((b * 16 + n) * 64 + c) * 160 + 16 * nt + col] = ap[nt]; agg[(size_t)((b * 16 + n) * 64 + c) * 160 + 80 + 16 * nt + col] = h[nt]; } }
#pragma unroll
            for (int nt = 0; nt < 5; ++nt) { h[nt] = 0.f; ap[nt] = 1.f; }
        }
        const int s0 = it < 8 ? 128 * c + 16 * it : -16;
        unsigned short gv[20];
        if (PASS == 2) {
#pragma unroll
            for (int nt = 0; nt < 5; ++nt)
#pragma unroll
                for (int r = 0; r < 4; ++r) gv[nt * 4 + r] = AG[(size_t)(b * 8192 + s0 + 4 * quad + r) * RGW + 80 * n + 16 * nt + col];
        }
        bf16x8 af[3];
        const int s = s0 + col;
#pragma unroll
        for (int ks = 0; ks < 3; ++ks) {
            const int ch = 32 * ks + 8 * quad;
            if (ch < 80) {
                const f32x4 b0 = *(const LAS f32x4*)(cb + ch), b1 = *(const LAS f32x4*)(cb + ch + 4);
                float xc[8] = {b0.x, b0.y, b0.z, b0.w, b1.x, b1.y, b1.z, b1.w};
                u32x4 wv[4];
#pragma unroll
                for (int j = 0; j < 4; ++j) { const int r = tok_row(b, s - 3 + j); wv[j] = *(const u32x4*)(AX + (size_t)(r < 0 ? 16384 : r) * RGW + 80 * n + ch); if (r < 0) wv[j] = (u32x4){0u, 0u, 0u, 0u}; }
#pragma unroll
                for (int j = 0; j < 4; ++j) {
                    const u32x4 w = wv[j];
                    const f32x4 w0 = *(const LAS f32x4*)(cw + j * 96 + ch), w1 = *(const LAS f32x4*)(cw + j * 96 + ch + 4);
                    xc[0] += w0.x * bflo(w.x); xc[1] += w0.y * bfhi(w.x); xc[2] += w0.z * bflo(w.y); xc[3] += w0.w * bfhi(w.y);
                    xc[4] += w1.x * bflo(w.z); xc[5] += w1.y * bfhi(w.z); xc[6] += w1.z * bflo(w.w); xc[7] += w1.w * bfhi(w.w);
                }
                u32x4 p; p.x = cvt_pk_bf16(xc[0], xc[1]); p.y = cvt_pk_bf16(xc[2], xc[3]); p.z = cvt_pk_bf16(xc[4], xc[5]); p.w = cvt_pk_bf16(xc[6], xc[7]);
                af[ks] = __builtin_bit_cast(bf16x8, p);
            } else af[ks] = (bf16x8){0, 0, 0, 0, 0, 0, 0, 0};
        }
#pragma unroll
        for (int nt = 0; nt < 5; ++nt) {
            f32x4 aR = {0.f, 0.f, 0.f, 0.f}, aI = {0.f, 0.f, 0.f, 0.f}, aX = {0.f, 0.f, 0.f, 0.f};
#pragma unroll
            for (int ks = 0; ks < 3; ++ks) {
                const bf16x8 bR = __builtin_bit_cast(bf16x8, bfr[(nt * 3 + ks) * 64 + lane]), bI = __builtin_bit_cast(bf16x8, bfr[((5 + nt) * 3 + ks) * 64 + lane]);
                aR = __builtin_amdgcn_mfma_f32_16x16x32_bf16(af[ks], bR, aR, 0, 0, 0);
                aI = __builtin_amdgcn_mfma_f32_16x16x32_bf16(af[ks], bI, aI, 0, 0, 0);
            }
            aX = __builtin_amdgcn_mfma_f32_16x16x32_bf16(af[nt >> 1], (nt & 1) ? idO : idE, aX, 0, 0, 0);
            float pa[4], ha[4];
#pragma unroll
            for (int r = 0; r < 4; ++r) {
                const float rr = sigm(aR[r] + ba[nt]), ii = sigm(aI[r] + bx[nt]);
                const float la = -rr * sp[nt], av = __expf(la), x2 = 2.f * la;
                const float om = x2 > -0.02f ? -x2 * (1.f + 0.5f * x2 * (1.f + x2 * (1.f / 3.f))) : 1.f - av * av;
                const float uu = sqrtf(om) * ii * aX[r];
                if (r == 0) { pa[0] = av; ha[0] = uu; } else { pa[r] = pa[r - 1] * av; ha[r] = av * ha[r - 1] + uu; }
            }
            float PA = 1.f, HA = 0.f;
#pragma unroll
            for (int j = 0; j < 3; ++j) { const float pj = __shfl(pa[3], col + 16 * j), hj = __shfl(ha[3], col + 16 * j); if (j < quad) { HA = pj * HA + hj; PA = pj * PA; } }
            const float hq = PA * h[nt] + HA;
            float o[4];
#pragma unroll
            for (int r = 0; r < 4; ++r) o[r] = pa[r] * hq + ha[r];
            h[nt] = __shfl(o[3], 48 + col);
            ap[nt] *= __shfl(pa[3] * PA, 48 + col);
            if (PASS == 2) {
#pragma unroll
                for (int r = 0; r < 4; ++r) AG[(size_t)(b * 8192 + s0 + 4 * quad + r) * RGW + 80 * n + 16 * nt + col] = f2bf(o[r] * bf2f(gv[nt * 4 + r]));
            }
        }
    }
    if (PASS == 1 && quad == 0) {
        float* dst = ntile == 9 ? aggm + (size_t)n * 160 : agg + (size_t)((b * 16 + n) * 64 + c) * 160;
#pragma unroll
        for (int nt = 0; nt < 5; ++nt) { dst[16 * nt + col] = ap[nt]; dst[80 + 16 * nt + col] = h[nt]; }
    }
    __syncthreads();
}

constexpr int HQE = 0, HKE = 17408, HKDT = 34816, HVT = 53248, HPB = 71680, HOB = 80896, HPART = 114688, HEM = 116736, HEB = 117248;
template <int PASS>
__device__ __forceinline__ void hg_pass(LAS unsigned char* lds, const Args& a) {
    int tid_ = threadIdx.x; asm volatile("" : "+v"(tid_));
    const int tid = tid_, lane = tid & 63, wid = tid >> 6, quad = lane >> 4, col = lane & 15;
    const int k = tid & 127, tq = tid >> 7;
    unsigned char* ws = a.ws;
    const bf16_t* Fb = (const bf16_t*)(ws + WS_F); const bf16_t* Vb = (const bf16_t*)(ws + WS_V); const bf16_t* Qb = (const bf16_t*)(ws + WS_Q);
    bf16_t* Gb = (bf16_t*)((unsigned char*)a.out + OUT_G);
    float* ST = (float*)((unsigned char*)a.out + OUT_HGS); float* STM = (float*)(ws + WS_HGSM); float* HD = (float*)(ws + WS_HGD);
    LAS float* PART = (LAS float*)(lds + HPART); LAS float* EM = (LAS float*)(lds + HEM); LAS float* EB = (LAS float*)(lds + HEB); LAS float* OB = (LAS float*)(lds + HOB);
    const int nunits = PASS == 0 ? 520 : 512;
    for (int u = blockIdx.x; u < nunits; u += gridDim.x) {
        const bool meta = u >= 512;
        const int hh = meta ? u - 512 : (u >> 5) & 7, b = meta ? 0 : u >> 8, j = u & 31, nchunk = meta ? 1 : 4;
        const float lbv = __builtin_amdgcn_rcpf(1.f + __expf(a.in[11][1024 + hh * 128 + k] - a.in[11][hh * 128 + k]));
        f32x4 S[8];
        if (PASS == 0) {
#pragma unroll
            for (int kb = 0; kb < 8; ++kb) S[kb] = (f32x4){0.f, 0.f, 0.f, 0.f};
        } else {
            const float* sp = ST + (size_t)u * 16384 + 16 * wid + col;
#pragma unroll
            for (int kb = 0; kb < 8; ++kb)
#pragma unroll
                for (int r = 0; r < 4; ++r) S[kb][r] = sp[(16 * kb + 4 * quad + r) * 128];
        }
        float btot = 0.f;
        for (int ci = 0; ci < nchunk; ++ci) {
            const int s0 = meta ? -64 : 256 * j + 64 * ci;
            float bc[16], kv[16]; unsigned short vr[16], fr16[16]; float qv[16];
#pragma unroll
            for (int i = 0; i < 16; ++i) {
                const int r = tok_row(b, s0 + 16 * tq + i), rc = r < 0 ? 16384 : r;
                fr16[i] = Fb[(size_t)rc * DM + hh * 128 + k]; vr[i] = Vb[(size_t)rc * DM + hh * 128 + k];
                if (PASS == 2) qv[i] = bf2f(Qb[(size_t)rc * DM + hh * 128 + k]);
            }
            float csum = 0.f;
#pragma unroll
            for (int i = 0; i < 16; ++i) {
                const bool valid = !meta || tq == 3;
                float fl = bf2f(fr16[i]); fl = fminf(fmaxf(fl, -30.f), 30.f);
                const float e = __expf(-fl), sg = __builtin_amdgcn_rcpf(1.f + e);
                csum += valid ? __logf(lbv + (1.f - lbv) * sg) : 0.f; kv[i] = valid ? (1.f - lbv) * e * sg : 0.f;
                if (!valid) vr[i] = 0;
                bc[i] = csum;
            }
            PART[tq * 128 + k] = csum;
            __syncthreads();
            const float p0 = PART[k], p1 = PART[128 + k], p2 = PART[256 + k], p3 = PART[384 + k];
            const float off = tq == 0 ? 0.f : (tq == 1 ? p0 : (tq == 2 ? p0 + p1 : p0 + p1 + p2));
            const float blast = (p0 + p1) + (p2 + p3), mid = p0 + p1;
            btot += blast;
            {
                unsigned kw[8], vw[8];
#pragma unroll
                for (int i = 0; i < 8; ++i) {
                    const float e0 = __expf(blast - (off + bc[2 * i])), e1 = __expf(blast - (off + bc[2 * i + 1]));
                    kw[i] = cvt_pk_bf16(kv[2 * i] * e0, kv[2 * i + 1] * e1); vw[i] = (unsigned)vr[2 * i] | ((unsigned)vr[2 * i + 1] << 16);
                }
                LAS u32x4* kd = (LAS u32x4*)(lds + HKDT + k * 144 + tq * 32); kd[0] = (u32x4){kw[0], kw[1], kw[2], kw[3]}; kd[1] = (u32x4){kw[4], kw[5], kw[6], kw[7]};
                LAS u32x4* vt = (LAS u32x4*)(lds + HVT + k * 144 + tq * 32); vt[0] = (u32x4){vw[0], vw[1], vw[2], vw[3]}; vt[1] = (u32x4){vw[4], vw[5], vw[6], vw[7]};
            }
            if (PASS == 2) {
#pragma unroll
                for (int i = 0; i < 16; ++i) {
                    const float d = off + bc[i] - mid; const int t = 16 * tq + i;
                    *(LAS bf16_t*)(lds + HQE + t * 272 + k * 2) = f2bf(qv[i] * __expf(fminf(d, 80.f)));
                    *(LAS bf16_t*)(lds + HKE + t * 272 + k * 2) = f2bf(kv[i] * __expf(fminf(-d, 80.f)));
                }
            }
            if (tq == 0) { EB[k] = __expf(blast); EM[k] = __expf(mid); }
            __syncthreads();
            bf16x8 vf[2];
#pragma unroll
            for (int ks = 0; ks < 2; ++ks) vf[ks] = *(const LAS bf16x8*)(lds + HVT + (16 * wid + col) * 144 + ks * 64 + quad * 16);
            if (PASS == 2) {
                {
                    const int I = wid >> 1, sh = wid & 1;
                    f32x4 p0a = {0.f, 0.f, 0.f, 0.f}, p1a = {0.f, 0.f, 0.f, 0.f};
#pragma unroll
                    for (int ks = 0; ks < 4; ++ks) {
                        const bf16x8 qa = *(const LAS bf16x8*)(lds + HQE + (16 * I + col) * 272 + ks * 64 + quad * 16);
                        const bf16x8 k0 = *(const LAS bf16x8*)(lds + HKE + (32 * sh + col) * 272 + ks * 64 + quad * 16);
                        const bf16x8 k1 = *(const LAS bf16x8*)(lds + HKE + (32 * sh + 16 + col) * 272 + ks * 64 + quad * 16);
                        p0a = __builtin_amdgcn_mfma_f32_16x16x32_bf16(qa, k0, p0a, 0, 0, 0);
                        p1a = __builtin_amdgcn_mfma_f32_16x16x32_bf16(qa, k1, p1a, 0, 0, 0);
                    }
#pragma unroll
                    for (int r = 0; r < 4; ++r) { const int t = 16 * I + 4 * quad + r, sa = 32 * sh + col;
                        *(LAS bf16_t*)(lds + HPB + t * 144 + sa * 2) = sa <= t ? f2bf(p0a[r]) : (bf16_t)0;
                        *(LAS bf16_t*)(lds + HPB + t * 144 + (sa + 16) * 2) = sa + 16 <= t ? f2bf(p1a[r]) : (bf16_t)0; }
                }
                bf16x8 sf[4];
#pragma unroll
                for (int ks = 0; ks < 4; ++ks) {
                    const f32x4 ea = *(const LAS f32x4*)(EM + 32 * ks + 4 * quad), eb2 = *(const LAS f32x4*)(EM + 32 * ks + 16 + 4 * quad);
                    const f32x4 x0 = S[2 * ks] * ea, x1 = S[2 * ks + 1] * eb2;
                    u32x4 p; p.x = cvt_pk_bf16(x0.x, x0.y); p.y = cvt_pk_bf16(x0.z, x0.w); p.z = cvt_pk_bf16(x1.x, x1.y); p.w = cvt_pk_bf16(x1.z, x1.w);
                    sf[ks] = __builtin_bit_cast(bf16x8, p);
                }
                __syncthreads();
#pragma unroll
                for (int tt = 0; tt < 4; ++tt) {
                    f32x4 acc = {0.f, 0.f, 0.f, 0.f};
#pragma unroll
                    for (int ks = 0; ks < 2; ++ks) { const bf16x8 pa = *(const LAS bf16x8*)(lds + HPB + (16 * tt + col) * 144 + ks * 64 + quad * 16); acc = __builtin_amdgcn_mfma_f32_16x16x32_bf16(pa, vf[ks], acc, 0, 0, 0); }
#pragma unroll
                    for (int ks = 0; ks < 4; ++ks) {
                        const u32x2 lo = *(const LAS u32x2*)(lds + HQE + (16 * tt + col) * 272 + (32 * ks + 4 * quad) * 2), hi = *(const LAS u32x2*)(lds + HQE + (16 * tt + col) * 272 + (32 * ks + 16 + 4 * quad) * 2);
                        const u32x4 qq = {lo.x, lo.y, hi.x, hi.y};
                        acc = __builtin_amdgcn_mfma_f32_16x16x32_bf16(__builtin_bit_cast(bf16x8, qq), sf[ks], acc, 0, 0, 0);
                    }
#pragma unroll
                    for (int r = 0; r < 4; ++r) OB[(16 * tt + 4 * quad + r) * 132 + 16 * wid + col] = acc[r];
                }
            }
#pragma unroll
            for (int kb = 0; kb < 8; ++kb) {
                const f32x4 e4 = *(const LAS f32x4*)(EB + 16 * kb + 4 * quad);
                f32x4 sacc = S[kb] * e4;
#pragma unroll
                for (int ks = 0; ks < 2; ++ks) { const bf16x8 ka = *(const LAS bf16x8*)(lds + HKDT + (16 * kb + col) * 144 + ks * 64 + quad * 16); sacc = __builtin_amdgcn_mfma_f32_16x16x32_bf16(ka, vf[ks], sacc, 0, 0, 0); }
                S[kb] = sacc;
            }
            __syncthreads();
            if (PASS == 2) {
                const int t = tid >> 3, vs = (tid & 7) * 16;
                float o[16]; float ss = 0.f;
#pragma unroll
                for (int i = 0; i < 4; ++i) { const f32x4 x = *(const LAS f32x4*)(OB + t * 132 + vs + 4 * i); o[4 * i] = x.x; o[4 * i + 1] = x.y; o[4 * i + 2] = x.z; o[4 * i + 3] = x.w; ss += (x.x * x.x + x.y * x.y) + (x.z * x.z + x.w * x.w); }
                ss += __shfl_xor(ss, 1); ss += __shfl_xor(ss, 2); ss += __shfl_xor(ss, 4);
                const float rstd = rsqrtf(ss * (1.f / 128.f) + EPS);
                u32x4* gp = (u32x4*)(Gb + (size_t)(b * 8192 + s0 + t) * DM + hh * 128 + vs);
                const float* gn = a.in[12] + vs;
#pragma unroll
                for (int hf = 0; hf < 2; ++hf) {
                    const u32x4 gw = gp[hf]; u32x4 ow;
                    const unsigned gws[4] = {gw.x, gw.y, gw.z, gw.w}; unsigned ows[4];
#pragma unroll
                    for (int i = 0; i < 4; ++i) { const int e = 8 * hf + 2 * i; ows[i] = cvt_pk_bf16(o[e] * rstd * gn[e] * bflo(gws[i]), o[e + 1] * rstd * gn[e + 1] * bfhi(gws[i])); }
                    ow.x = ows[0]; ow.y = ows[1]; ow.z = ows[2]; ow.w = ows[3]; gp[hf] = ow;
                }
            }
        }
        if (PASS == 0) {
            float* sp = (meta ? STM + (size_t)hh * 16384 : ST + (size_t)u * 16384) + 16 * wid + col;
#pragma unroll
            for (int kb = 0; kb < 8; ++kb)
#pragma unroll
                for (int r = 0; r < 4; ++r) sp[(16 * kb + 4 * quad + r) * 128] = S[kb][r];
            if (!meta && tq == 0) HD[u * 128 + k] = __expf(btot);
        }
        __syncthreads();
    }
}
__device__ __forceinline__ void hg_pass_b(const Args& a) {
    float* ST = (float*)((unsigned char*)a.out + OUT_HGS); const float* STM = (const float*)(a.ws + WS_HGSM); const float* HD = (const float*)(a.ws + WS_HGD);
    for (int e = blockIdx.x * 512 + threadIdx.x; e < 16 * 16384; e += gridDim.x * 512) {
        const int bh = e >> 14, kv = e & 16383, k = kv >> 7, hh = bh & 7;
        float s = STM[hh * 16384 + kv];
#pragma unroll 8
        for (int j = 0; j < 32; ++j) { const int u = bh * 32 + j; const float d = ST[(size_t)u * 16384 + kv]; ST[(size_t)u * 16384 + kv] = s; s = HD[u * 128 + k] * s + d; }
    }
}


#ifndef RG_NAIVE
#define RG_NAIVE 0
#endif
#ifndef HG_NAIVE
#define HG_NAIVE 0
#endif
__device__ __forceinline__ void rg_naive(LAS unsigned char* lds, const Args& a) {
    if (blockIdx.x >= 32) return;
    const int b = blockIdx.x >> 4, n = blockIdx.x & 15, e = threadIdx.x, c = 80 * n + (e < 80 ? e : 0);
    LAS float* xs = (LAS float*)lds;
    const bf16_t* AX = (const bf16_t*)(a.ws + WS_AX); bf16_t* AG = (bf16_t*)(a.ws + WS_AG);
    float wa[80], wx[80];
#pragma unroll
    for (int d = 0; d < 80; ++d) { wa[d] = a.in[6][(size_t)n * 6400 + d * 80 + (e < 80 ? e : 0)]; wx[d] = a.in[8][(size_t)n * 6400 + d * 80 + (e < 80 ? e : 0)]; }
    const float ba = a.in[7][c], bx = a.in[9][c], sp = 8.f * log1pf(expf(-a.in[10][c])), cb = a.in[5][c];
    const float c0 = a.in[4][c], c1 = a.in[4][1280 + c], c2 = a.in[4][2560 + c], c3 = a.in[4][3840 + c];
    float h = 0.f, x0 = 0.f, x1 = 0.f, x2 = 0.f;
    for (int s = -16; s < 8192; ++s) {
        const float x3 = bf2f(AX[(size_t)tok_row(b, s) * RGW + c]);
        const float xc = cb + c0 * x0 + c1 * x1 + c2 * x2 + c3 * x3;
        x0 = x1; x1 = x2; x2 = x3;
        LAS float* xb = xs + (s & 1) * 80;
        if (e < 80) xb[e] = xc;
        __syncthreads();
        float r = ba, ii = bx;
#pragma unroll
        for (int d = 0; d < 80; ++d) { const float xv = xb[d]; r += xv * wa[d]; ii += xv * wx[d]; }
        const float la = -sp / (1.f + expf(-r)), av = expf(la), uu = sqrtf(-expm1f(2.f * la)) * xc / (1.f + expf(-ii));
        h = av * h + uu;
        if (s >= 0 && e < 80) { bf16_t* p = AG + (size_t)(b * 8192 + s) * RGW + c; *p = f2bf(h * bf2f(*p)); }
    }
    __syncthreads();
}
__device__ __forceinline__ void hg_naive(LAS unsigned char* lds, const Args& a) {
    if (blockIdx.x >= 16) return;
    const int b = blockIdx.x >> 3, hh = blockIdx.x & 7, v = threadIdx.x & 127; const bool act = threadIdx.x < 128;
    LAS float* fg = (LAS float*)lds; LAS float* kk = fg + 256; LAS float* qq = fg + 512; LAS float* red = fg + 768;
    const bf16_t* Fb = (const bf16_t*)(a.ws + WS_F); const bf16_t* Vb = (const bf16_t*)(a.ws + WS_V); const bf16_t* Qb = (const bf16_t*)(a.ws + WS_Q);
    bf16_t* Gb = (bf16_t*)((unsigned char*)a.out + OUT_G);
    const float lbv = 1.f / (1.f + expf(a.in[11][1024 + hh * 128 + v] - a.in[11][hh * 128 + v])), gn = a.in[12][v];
    float S[128];
#pragma unroll
    for (int k = 0; k < 128; ++k) S[k] = 0.f;
    for (int s = -16; s < 8192; ++s) {
        const int row = tok_row(b, s), par = (s & 1) * 128;
        const float fl = bf2f(Fb[(size_t)row * DM + hh * 128 + v]), sg = 1.f / (1.f + expf(-fl));
        const float vv = bf2f(Vb[(size_t)row * DM + hh * 128 + v]);
        if (act) { fg[par + v] = lbv + (1.f - lbv) * sg; kk[par + v] = (1.f - lbv) / (1.f + expf(fl)); qq[par + v] = s >= 0 ? bf2f(Qb[(size_t)row * DM + hh * 128 + v]) : 0.f; }
        __syncthreads();
        float o = 0.f;
#pragma unroll
        for (int k = 0; k < 128; ++k) { S[k] = fg[par + k] * S[k] + kk[par + k] * vv; o += S[k] * qq[par + k]; }
        const float ss = wave_sum(o * o);
        if ((threadIdx.x & 63) == 0 && act) red[(s & 1) * 2 + (threadIdx.x >> 6)] = ss;
        __syncthreads();
        if (s >= 0 && act) { const float tot = red[(s & 1) * 2] + red[(s & 1) * 2 + 1]; bf16_t* p = Gb + (size_t)(b * 8192 + s) * DM + hh * 128 + v; *p = f2bf(o * rsqrtf(tot * (1.f / 128.f) + EPS) * gn * bf2f(*p)); }
    }
    __syncthreads();
}

__device__ __forceinline__ u32x4 pack8(const f32x4& v0, const f32x4& v1) { u32x4 w; w.x = cvt_pk_bf16(v0[0], v0[1]); w.y = cvt_pk_bf16(v0[2], v0[3]); w.z = cvt_pk_bf16(v1[0], v1[1]); w.w = cvt_pk_bf16(v1[2], v1[3]); return w; }
struct EpiP1 {
    static constexpr bool PERM = true, AFTER_DRAIN = false;
    unsigned char* wsb; unsigned char* outb; int pn_off;
    __device__ __forceinline__ void operator()(const f32x4 (&acc)[2][2][4][2], const Unit& u, int wr, int wc, int fr, int fq) const {
        const int pn = u.pn + pn_off;
        const int seg = pn < 5 ? 0 : (pn < 10 ? 1 : (pn < 14 ? 2 : (pn < 18 ? 3 : (pn < 22 ? 4 : (pn < 26 ? 5 : (pn < 30 ? 6 : 7))))));
        const int ct = pn - (seg == 0 ? 0 : (seg == 1 ? 5 : (seg == 2 ? 10 : (seg == 3 ? 14 : (seg == 4 ? 18 : (seg == 5 ? 22 : (seg == 6 ? 26 : 30)))))));
        const int ld = seg < 2 ? RGW : DM, act = seg == 1 ? 1 : ((seg == 2 || seg == 5) ? 2 : (seg >= 6 ? 3 : 0));
        const size_t boff = seg == 0 ? WS_AX : (seg == 1 ? WS_AG : (seg == 2 ? WS_Q : (seg == 3 ? WS_F : (seg == 4 ? WS_V : (seg == 5 ? OUT_G : (seg == 6 ? WS_GA : WS_GB))))));
        bf16_t* base = (bf16_t*)((seg == 5 ? outb : wsb) + boff);
        if (act != 0 && u.pm >= 64) return;
        const float al = act == 1 ? 1.5957691216f : 1.f, be = act == 1 ? 0.0713548163f : 0.f;
        const int row0 = u.pm * 256 + wr * 64 + fr, col0 = ct * 256 + wc * 32 + 8 * fq;
#pragma unroll
        for (int ai = 0; ai < 2; ++ai)
#pragma unroll
            for (int m = 0; m < 4; ++m) { bf16_t* rowp = base + (size_t)(row0 + ai * 128 + m * 16) * ld + col0;
#pragma unroll
                for (int bj = 0; bj < 2; ++bj) { f32x4 v0 = acc[ai][bj][m][0], v1 = acc[ai][bj][m][1];
                    if (act) {
#pragma unroll
                        for (int i = 0; i < 4; ++i) { const float x = v0[i], y = v1[i]; const float sx = sigm(x * (al + be * x * x)), sy = sigm(y * (al + be * y * y)); v0[i] = act == 3 ? sx : x * sx; v1[i] = act == 3 ? sy : y * sy; } }
                    *(u32x4*)(rowp + bj * 128) = pack8(v0, v1); } }
    }
};
struct EpiGates {
    static constexpr bool PERM = true, AFTER_DRAIN = false;
    bf16_t *GA, *GB;
    __device__ __forceinline__ void operator()(const f32x4 (&acc)[2][2][4][2], const Unit& u, int wr, int wc, int fr, int fq) const {
        bf16_t* base = u.pn < 4 ? GA : GB; const int ct = u.pn & 3;
        const int row0 = u.pm * 256 + wr * 64 + fr, col0 = ct * 256 + wc * 32 + 8 * fq;
#pragma unroll
        for (int ai = 0; ai < 2; ++ai)
#pragma unroll
            for (int m = 0; m < 4; ++m) { bf16_t* rowp = base + (size_t)(row0 + ai * 128 + m * 16) * DM + col0;
#pragma unroll
                for (int bj = 0; bj < 2; ++bj) { f32x4 v0 = acc[ai][bj][m][0], v1 = acc[ai][bj][m][1];
#pragma unroll
                    for (int i = 0; i < 4; ++i) { v0[i] = sigm(v0[i]); v1[i] = sigm(v1[i]); }
                    *(u32x4*)(rowp + bj * 128) = pack8(v0, v1); } }
    }
};
#ifndef ZERO_A
#define ZERO_A 0
#endif
#ifndef ZERO_B
#define ZERO_B 0
#endif
template <int MODE> struct EpiMerge {
    static constexpr bool PERM = true, AFTER_DRAIN = false;
    const bf16_t* GT; const bf16_t* T1; bf16_t* O;
    __device__ __forceinline__ void operator()(const f32x4 (&acc)[2][2][4][2], const Unit& u, int wr, int wc, int fr, int fq) const {
        const int row0 = u.pm * 256 + wr * 64 + fr, col0 = u.pn * 256 + wc * 32 + 8 * fq;
#pragma unroll
        for (int ai = 0; ai < 2; ++ai)
#pragma unroll
            for (int m = 0; m < 4; ++m) { const size_t off = (size_t)(row0 + ai * 128 + m * 16) * DM + col0;
#pragma unroll
                for (int bj = 0; bj < 2; ++bj) { f32x4 v0 = acc[ai][bj][m][0], v1 = acc[ai][bj][m][1];
                    const u32x4 gw = *(const u32x4*)(GT + off + bj * 128);
                    v0[0] *= bflo(gw.x); v0[1] *= bfhi(gw.x); v0[2] *= bflo(gw.y); v0[3] *= bfhi(gw.y); v1[0] *= bflo(gw.z); v1[1] *= bfhi(gw.z); v1[2] *= bflo(gw.w); v1[3] *= bfhi(gw.w);
                    if ((MODE == 0 && ZERO_A) || (MODE == 1 && ZERO_B)) { v0 = (f32x4){0.f, 0.f, 0.f, 0.f}; v1 = v0; }
                    if (MODE == 1) { const u32x4 tw = *(const u32x4*)(T1 + off + bj * 128);
                        v0[0] += bflo(tw.x); v0[1] += bfhi(tw.x); v0[2] += bflo(tw.y); v0[3] += bfhi(tw.y); v1[0] += bflo(tw.z); v1[1] += bfhi(tw.z); v1[2] += bflo(tw.w); v1[3] += bfhi(tw.w); }
                    *(u32x4*)(O + off + bj * 128) = pack8(v0, v1); } }
    }
};
struct EpiRes {
    static constexpr bool PERM = false, AFTER_DRAIN = false;
    const float* base; float* out;
    __device__ __forceinline__ void operator()(const f32x4 (&acc)[2][2][4][2], const Unit& u, int wr, int wc, int fr, int fq) const {
        const int row0 = u.pm * 256 + wr * 64 + fr, col0 = u.pn * 256 + wc * 32 + 4 * fq;
#pragma unroll
        for (int ai = 0; ai < 2; ++ai)
#pragma unroll
            for (int m = 0; m < 4; ++m) { const size_t off = (size_t)(row0 + ai * 128 + m * 16) * DM + col0;
#pragma unroll
                for (int bj = 0; bj < 2; ++bj)
#pragma unroll
                    for (int n = 0; n < 2; ++n) { const f32x4 bs = *(const f32x4*)(base + off + bj * 128 + n * 16); *(f32x4*)(out + off + bj * 128 + n * 16) = bs + acc[ai][bj][m][n]; } }
    }
};
struct EpiFfn {
    static constexpr bool PERM = true, AFTER_DRAIN = false;
    bf16_t* O;
    __device__ __forceinline__ void operator()(const f32x4 (&acc)[2][2][4][2], const Unit& u, int wr, int wc, int fr, int fq) const {
        const int row0 = u.pm * 256 + wr * 64 + fr, col0 = u.pn * 128 + wc * 32 + 8 * fq;
#pragma unroll
        for (int ai = 0; ai < 2; ++ai)
#pragma unroll
            for (int m = 0; m < 4; ++m) { f32x4 v0, v1;
#pragma unroll
                for (int i = 0; i < 4; ++i) { const float g0 = acc[ai][0][m][0][i], g1 = acc[ai][0][m][1][i]; v0[i] = g0 * sigm(g0) * acc[ai][1][m][0][i]; v1[i] = g1 * sigm(g1) * acc[ai][1][m][1][i]; }
                *(u32x4*)(O + (size_t)(row0 + ai * 128 + m * 16) * DFF + col0) = pack8(v0, v1); }
    }
};


#ifndef SELFCHECK
#define SELFCHECK 0
#endif
constexpr size_t WS_FLAGS = 512 * 1024;
__device__ __forceinline__ unsigned hash32(unsigned x) { x ^= x >> 16; x *= 0x7feb352du; x ^= x >> 15; x *= 0x846ca68bu; x ^= x >> 16; return x; }
__device__ __forceinline__ float dot_bf_w(const bf16_t* arow, const float* W, int K, int N, int col, int lane) {
    float s = 0.f; for (int k = lane; k < K; k += 64) s += bf2f(arow[k]) * W[(size_t)k * N + col]; return wave_sum(s);
}
__device__ __forceinline__ void flag_err(unsigned char* ws, int p, float got, float ref, int lane) {
    const float e = fabsf(got - ref) / (fabsf(ref) + 0.5f);
    if (lane == 0) atomicMax((unsigned*)(ws + WS_FLAGS) + p, __float_as_uint(e != e ? 1e9f : e));
}
__device__ __forceinline__ float act_f(float x, int act) { return act == 0 ? x : (act == 1 ? 0.5f * x * (1.f + tanhf(0.7978845608f * (x + 0.044715f * x * x * x))) : x / (1.f + expf(-x))); }
template <int PH> __device__ __forceinline__ void selfcheck(const Args& a) {
    unsigned char* ws = a.ws; const int lane = threadIdx.x & 63, gw = blockIdx.x * 8 + (threadIdx.x >> 6);
    const bf16_t* XN = (const bf16_t*)(ws + WS_XN);
    for (int smp = 0; smp < 4; ++smp) {
        const unsigned hsh = hash32((unsigned)(gw * 4 + smp) * 2654435761u + PH * 977u);
        if (PH == 1) {
            const int col = hsh % N1; int row = (hsh >> 13) % (MX + (SELFCHECK == 1 ? 16 : 0));
            const int seg = col < 1280 ? 0 : (col < 2560 ? 1 : (col < 3584 ? 2 : (col < 4608 ? 3 : (col < 5632 ? 4 : 5))));
            const int act = seg == 1 ? 1 : ((seg == 2 || seg == 5) ? 2 : 0);
            if (act != 0 && row >= MX) row -= 64;
            const float ref = act_f(dot_bf_w(XN + (size_t)row * DM, a.in[3], DM, 8704, col, lane), act);
            const size_t boff = seg == 0 ? WS_AX : (seg == 1 ? WS_AG : (seg == 2 ? WS_Q : (seg == 3 ? WS_F : (seg == 4 ? WS_V : OUT_G))));
            const bf16_t* base = (const bf16_t*)((seg == 5 ? (unsigned char*)a.out : ws) + boff);
            const int ld = seg < 2 ? RGW : DM, c0 = seg == 0 ? 0 : (seg == 1 ? 1280 : (seg == 2 ? 2560 : (seg == 3 ? 3584 : (seg == 4 ? 4608 : 5632))));
            flag_err(ws, 0 + seg, bf2f(base[(size_t)row * ld + col - c0]), ref, lane);
        }
        if (PH == 2) {
            const int col = hsh % 2048, row = (hsh >> 13) % MX;
            const float ref = 1.f / (1.f + expf(-dot_bf_w(XN + (size_t)row * DM, a.in[3], DM, 8704, N1 + col, lane)));
            const bf16_t* base = col < 1024 ? (const bf16_t*)(ws + WS_GA) : (const bf16_t*)(ws + WS_GB);
            const float got = bf2f(base[(size_t)row * DM + (col & 1023)]);
            flag_err(ws, 6, got, ref, lane);
            const bf16_t* wr = (const bf16_t*)(ws + WS_WIN) + (size_t)(N1 + col) * DM; float s2 = 0.f;
            for (int k = lane; k < DM; k += 64) s2 += bf2f(XN[(size_t)row * DM + k]) * bf2f(wr[k]);
            const float ref2 = 1.f / (1.f + expf(-wave_sum(s2)));
            flag_err(ws, 16, ref2, ref, lane);
            flag_err(ws, 17, got, ref2, lane);
            if (lane == 0 && !(fabsf(got - ref) < 0.03f)) { atomicAdd((unsigned*)(ws + WS_FLAGS) + 20, 1u); if (got > 1.01f || got < -0.01f) atomicAdd((unsigned*)(ws + WS_FLAGS) + 21, 1u); }
        }
        if (PH == 3) {
            const int col = hsh % 1024, row = (hsh >> 13) % MX;
            const float pa = dot_bf_w((const bf16_t*)(ws + WS_AG) + (size_t)row * RGW, a.in[13], RGW, DM, col, lane);
            const float pb = dot_bf_w((const bf16_t*)((unsigned char*)a.out + OUT_G) + (size_t)row * DM, a.in[14], DM, DM, col, lane);
            const float ref = bf2f(((const bf16_t*)(ws + WS_GA))[(size_t)row * DM + col]) * pa + bf2f(((const bf16_t*)(ws + WS_GB))[(size_t)row * DM + col]) * pb;
            flag_err(ws, 7, bf2f(((const bf16_t*)(ws + WS_MG))[(size_t)row * DM + col]), ref, lane);
        }
        if (PH == 4) {
            const int col = hsh % 1024, row = (hsh >> 13) % MX;
            const float ref = a.in[0][(size_t)row * DM + col] + dot_bf_w((const bf16_t*)(ws + WS_MG) + (size_t)row * DM, a.in[15], DM, DM, col, lane);
            flag_err(ws, 8, a.out[(size_t)row * DM + col], ref, lane);
        }
        if (PH == 5) {
            const int col = hsh % 1024, row = (hsh >> 13) % MX; float s2 = 0.f;
            for (int k = lane; k < DM; k += 64) { const float v = a.out[(size_t)row * DM + k]; s2 += v * v; }
            const float ref = a.out[(size_t)row * DM + col] * rsqrtf(wave_sum(s2) / 1024.f + EPS) * a.in[16][col];
            flag_err(ws, 9, bf2f(XN[(size_t)row * DM + col]), ref, lane);
        }
        if (PH == 6) {
            const int col = hsh % DFF, row = (hsh >> 13) % MX;
            const float gg = dot_bf_w(XN + (size_t)row * DM, a.in[17], DM, 2 * DFF, col, lane), uu = dot_bf_w(XN + (size_t)row * DM, a.in[17], DM, 2 * DFF, DFF + col, lane);
            flag_err(ws, 10, bf2f(((const bf16_t*)(ws + WS_AG))[(size_t)row * DFF + col]), act_f(gg, 2) * uu, lane);
        }
        if (PH == 7) {
            const int col = hsh % 1024, row = (hsh >> 13) % MX;
            const float ref = a.in[0][(size_t)row * DM + col] + dot_bf_w((const bf16_t*)(ws + WS_AX) + (size_t)row * DM, a.in[15], DM, DM, col, lane)
                            + dot_bf_w((const bf16_t*)(ws + WS_AG) + (size_t)row * DFF, a.in[18], DFF, DM, col, lane);
            flag_err(ws, 11, a.out[(size_t)row * DM + col], ref, lane);
        }
    }
}

#ifndef N_LAUNCH
#define N_LAUNCH 1
#endif
__global__ void __launch_bounds__(512, 2) mega(Args a) {
    extern __shared__ __attribute__((aligned(16))) unsigned char lds_raw[];
    LAS unsigned char* lds = (LAS unsigned char*)lds_raw;
    cg::grid_group grid = cg::this_grid();
    const int lo = a.ph_lo, hi = a.ph_hi;
#define IN(k) (lo <= (k) && (k) < hi)
#define SEAM(k) do { if (IN(k) && IN((k) + 1)) { grid.sync(); } } while (0)
    unsigned char* ws = a.ws; const int G = gridDim.x, bid = blockIdx.x;
    bf16_t* XN = (bf16_t*)(ws + WS_XN);
    if (IN(0)) p0_prologue(lds, a);
    if (SELFCHECK && bid == 0 && threadIdx.x < 64) ((unsigned*)(ws + WS_FLAGS))[threadIdx.x] = 0u;
    SEAM(0);
    if (IN(1)) { pg8::Gemm g{XN, (const bf16_t*)(ws + WS_WIN), MT, N1, DM}; pg8::StaticOrder S; S.init(MT, N1, G, bid);
      EpiP1 E{ws, (unsigned char*)a.out, 0};
      pg8::gemm_phase<EpiP1, pg8::StaticOrder, true, true>(lds, g, S, E); }
    SEAM(1);
    if (SELFCHECK) { selfcheck<1>(a); __threadfence(); grid.sync(); __threadfence(); }
    if (IN(2)) { if (!RG_NAIVE) rg_pass<1>(lds, a); if (!HG_NAIVE) hg_pass<0>(lds, a); }
    SEAM(2);
    if (IN(3)) { if (!HG_NAIVE) hg_pass_b(a); }
    SEAM(3);
    if (IN(4)) { if (RG_NAIVE) rg_naive(lds, a); else rg_pass<2>(lds, a);
                 if (HG_NAIVE) hg_naive(lds, a); else hg_pass<2>(lds, a); }
    SEAM(4);
    if (IN(5)) { pg8::Gemm g{XN, (const bf16_t*)(ws + WS_WIN) + (size_t)N1 * DM, MX, 2048, DM}; pg8::StaticOrder S; S.init(MX, 2048, G, bid);
      EpiP1 E{ws, (unsigned char*)a.out, 26};
      pg8::gemm_phase<EpiP1, pg8::StaticOrder, true, true>(lds, g, S, E); }
    SEAM(5);
    if (SELFCHECK) { selfcheck<2>(a); __threadfence(); grid.sync(); __threadfence(); }
    if (IN(6)) { pg8::StaticOrder S; S.init(MX, DM, G, bid);
      { pg8::Gemm g{(const bf16_t*)(ws + WS_AG), (const bf16_t*)(ws + WS_WPA), MX, DM, RGW};
        EpiMerge<0> E{(const bf16_t*)(ws + WS_GA), nullptr, (bf16_t*)(ws + WS_T1)};
        pg8::gemm_phase<EpiMerge<0>, pg8::StaticOrder, false, true>(lds, g, S, E); }
      __syncthreads();
      { pg8::Gemm g{(const bf16_t*)((unsigned char*)a.out + OUT_G), (const bf16_t*)(ws + WS_WPB), MX, DM, DM};
        EpiMerge<1> E{(const bf16_t*)(ws + WS_GB), (const bf16_t*)(ws + WS_T1), (bf16_t*)(ws + WS_MG)};
        pg8::gemm_phase<EpiMerge<1>, pg8::StaticOrder, false, true>(lds, g, S, E); } }
    SEAM(6);
    if (SELFCHECK) { selfcheck<3>(a); __threadfence(); grid.sync(); __threadfence(); }
    if (IN(7)) { pg8::Gemm g{(const bf16_t*)(ws + WS_MG), (const bf16_t*)(ws + WS_WOUT), MX, DM, DM}; pg8::StaticOrder S; S.init(MX, DM, G, bid);
      EpiRes E{a.in[0], a.out};
      pg8::gemm_phase<EpiRes, pg8::StaticOrder, false, true>(lds, g, S, E); }
    SEAM(7);
    if (SELFCHECK) { selfcheck<4>(a); __threadfence(); grid.sync(); __threadfence(); }
    if (IN(8)) { for (int m = bid * 8 + __builtin_amdgcn_readfirstlane(threadIdx.x >> 6); m < MX; m += G * 8) norm_row_bf16(a.out + (size_t)m * DM, a.in[16], XN + (size_t)m * DM, (int)__lane_id()); }
    SEAM(8);
    if (SELFCHECK) { selfcheck<5>(a); __threadfence(); grid.sync(); __threadfence(); }
    if (IN(9)) { pg8::Gemm g{XN, (const bf16_t*)(ws + WS_WFI), MX, 2 * DFF, DM}; pg8::StaticOrder S; S.init(MX, 2 * DFF, G, bid);
      EpiFfn E{(bf16_t*)(ws + WS_AG)};
      pg8::gemm_phase<EpiFfn, pg8::StaticOrder, true, true>(lds, g, S, E); }
    SEAM(9);
    if (SELFCHECK) { selfcheck<6>(a); __threadfence(); grid.sync(); __threadfence(); }
    if (IN(10)) { pg8::Gemm g{(const bf16_t*)(ws + WS_AG), (const bf16_t*)(ws + WS_WFD), MX, DM, DFF}; pg8::StaticOrder S; S.init(MX, DM, G, bid);
      EpiRes E{a.out, a.out};
      pg8::gemm_phase<EpiRes, pg8::StaticOrder, false, true>(lds, g, S, E); }
    SEAM(10);
    if (SELFCHECK) { selfcheck<7>(a); __threadfence(); grid.sync(); __threadfence(); }
    if (IN(11)) { for (int m = bid * 8 + __builtin_amdgcn_readfirstlane(threadIdx.x >> 6); m < MX; m += G * 8) {
        const int lane = (int)__lane_id();
        float* row = a.out + (size_t)m * DM; f32x4 v[4]; float s = 0.f;
#pragma unroll
        for (int j = 0; j < 4; ++j) { v[j] = ((const f32x4*)row)[lane + 64 * j]; s += (v[j].x * v[j].x + v[j].y * v[j].y) + (v[j].z * v[j].z + v[j].w * v[j].w); }
        const float rstd = rsqrtf(wave_sum(s) * (1.f / 1024.f) + EPS);
#pragma unroll
        for (int j = 0; j < 4; ++j) { const f32x4 gg = ((const f32x4*)a.in[19])[lane + 64 * j]; ((f32x4*)row)[lane + 64 * j] = v[j] * rstd * gg; }
    } }
    if (SELFCHECK) { __threadfence(); grid.sync(); __threadfence(); if (bid == 0 && threadIdx.x == 0) { const unsigned* fl = (const unsigned*)(ws + WS_FLAGS);
        const int mask = (__uint_as_float(fl[6]) > 0.05f ? 1 : 0) + (__uint_as_float(fl[16]) > 0.05f ? 2 : 0) + (__uint_as_float(fl[17]) > 0.05f ? 4 : 0) + (fl[21] > 0 ? 8 : 0);
        const int kk = 1 + (int)fl[20]; for (int i = 0; i < kk; ++i) a.out[i] = 1000.f * (1 + mask); } }
}

extern "C" void kernel_launch(void* const* d_in, const int* in_sizes, int n_in, void* d_out, int out_size, void* d_ws, size_t ws_size, hipStream_t stream) {
    static int ok = 0;
    if (!ok) { (void)hipFuncSetAttribute((const void*)mega, hipFuncAttributeMaxDynamicSharedMemorySize, LDS_BYTES); ok = 1; }
    Args a{};
    for (int i = 0; i < 20; ++i) a.in[i] = (const float*)d_in[i];
    a.out = (float*)d_out; a.ws = (unsigned char*)d_ws;
    if (N_LAUNCH == 1) {
        a.ph_lo = 0; a.ph_hi = 12;
        void* args[] = {&a};
        hipError_t e = hipLaunchCooperativeKernel((const void*)mega, dim3(256), dim3(512), args, LDS_BYTES, stream);
        if (e != hipSuccess) fprintf(stderr, "cooperative launch failed: %s\n", hipGetErrorString(e));
    } else {
        for (int k = 0; k < 12; ++k) { a.ph_lo = k; a.ph_hi = k + 1; hipLaunchKernelGGL(mega, dim3(256), dim3(512), LDS_BYTES, stream, a); }
    }
}
```

```cpp
#include <hip/hip_runtime.h>
#include <hip/hip_cooperative_groups.h>
#include <cstdio>
#include <cstdint>
namespace cg = cooperative_groups;
namespace pg8 {
#define PG8_LAS __attribute__((address_space(3)))
typedef unsigned short bf16_t;
typedef short bf16x8 __attribute__((ext_vector_type(8)));
typedef float f32x4 __attribute__((ext_vector_type(4)));
typedef unsigned u32x4 __attribute__((ext_vector_type(4)));
constexpr int BM = 256, BK = 64, HALF = 128, HTB = HALF * BK * 2  , STAGE_BYTES = 8 * HTB, NXCD = 8, WGM = 8;

__host__ __device__ __forceinline__ int lds_byte(int r, int c) { const int st = (r >> 4) * 2 + (c >> 5), rr = r & 15, cc = c & 31, ob = rr * 64 + cc * 2; return st * 1024 + (ob ^ (((ob >> 9) & 1) << 5)); }
__host__ __device__ __forceinline__ void stage_rc(int b, int& R, int& C) { const int st = b / 1024, sb = b % 1024, swz = sb ^ (((sb >> 9) & 1) << 5); R = (st >> 1) * 16 + swz / 64; C = (st & 1) * 32 + (swz % 64) / 2; }
__host__ __device__ __forceinline__ int perm32(int rho) { const int n = rho >> 4, i = rho & 15; return 8 * (i >> 2) + 4 * n + (i & 3); }

struct Unit { int pm, pn; };
struct Gemm { const bf16_t* A; const bf16_t* Bt; int M, N, K; };

struct StaticOrder {
    int nM, nN, nwg, G, c;
    __host__ __device__ void init(int M, int N, int G_, int c_) { nM = M / BM; nN = N / BM; nwg = nM * nN; G = G_; c = c_; }
    __host__ __device__ bool next(int i, Unit& u) const {
        const long L = (long)i * G + c; if (L >= nwg) return false;
        int wgid = (int)L; { const int q = nwg / NXCD, r = nwg % NXCD, xcd = wgid % NXCD, off = wgid / NXCD; wgid = (xcd < r ? xcd * (q + 1) : r * (q + 1) + (xcd - r) * q) + off; }
        const int nig = WGM * nN, gid = wgid / nig, fm = gid * WGM, gsz = (nM - fm) < WGM ? (nM - fm) : WGM;
        u.pm = fm + ((wgid % nig) % gsz); u.pn = (wgid % nig) / gsz; return true;
    }
    __device__ __forceinline__ void a_ready(const Unit&) const {}
    __device__ __forceinline__ void done(const Unit&) const {}
};
__device__ __forceinline__ unsigned cvt_pk_bf16(float lo, float hi) { unsigned r; asm volatile("v_cvt_pk_bf16_f32 %0, %1, %2" : "=v"(r) : "v"(lo), "v"(hi)); return r; }
template <class Epi, class Sched, bool ALIGN_EPI = false, bool SP2 = false>
__device__ __forceinline__ void gemm_phase(PG8_LAS unsigned char* lds, const Gemm g, const Sched& S, const Epi& E) {
    int tid_ = threadIdx.x; asm volatile("" : "+v"(tid_));
    const int tid = tid_, wid = __builtin_amdgcn_readfirstlane(tid >> 6), lane = tid & 63, wr = wid >> 2, wc = wid & 3, fr = lane & 15, fq = lane >> 4;
    const int K = g.K, nt = K / BK;
    unsigned voffA[2], voffB[2];
#pragma unroll
    for (int i = 0; i < 2; ++i) { int R, C; stage_rc(tid * 16 + i * 8192, R, C); const int Rb = Epi::PERM ? ((R & ~31) + perm32(R & 31)) : R;
        voffA[i] = (unsigned)(R * K + C) * 2u; voffB[i] = (unsigned)(Rb * K + C) * 2u; }
    const size_t kstep = (size_t)(BK * 2);
    const size_t hstep = (size_t)HALF * K * 2;
    const size_t tstep = 2 * hstep;
    const unsigned ldsw = (unsigned)wid * 1024u;
    const int aoff = lds_byte(wr * 64 + fr, fq * 8), boff = lds_byte(wc * 32 + fr, fq * 8);
#define PG8_SA(b, h) (((b) * 2 + (h)) * HTB)
#define PG8_SB(b, h) ((4 + (b) * 2 + (h)) * HTB)
#define PG8_STAGE(bufoff, gbase, voff) do { _Pragma("unroll") for (int _i = 0; _i < 2; ++_i) \
        __builtin_amdgcn_global_load_lds((const unsigned*)((const char*)(gbase) + (voff)[_i]), (PG8_LAS unsigned*)(lds + (bufoff) + ldsw + _i * 8192), 16, 0, 0); } while (0)
#define PG8_LDA(dst, b, h) do { _Pragma("unroll") for (int m = 0; m < 4; ++m) _Pragma("unroll") for (int k = 0; k < 2; ++k) dst[m][k] = *(const PG8_LAS bf16x8*)(lds + PG8_SA(b, h) + aoff + m * 2048 + k * 1024); } while (0)
#define PG8_LDB(dst, b, h) do { _Pragma("unroll") for (int n = 0; n < 2; ++n) _Pragma("unroll") for (int k = 0; k < 2; ++k) dst[n][k] = *(const PG8_LAS bf16x8*)(lds + PG8_SB(b, h) + boff + n * 2048 + k * 1024); } while (0)
#define PG8_MMA(ai, bj, At, Bt) do { __builtin_amdgcn_s_setprio(1); _Pragma("unroll") for (int m = 0; m < 4; ++m) _Pragma("unroll") for (int n = 0; n < 2; ++n) _Pragma("unroll") for (int k = 0; k < 2; ++k) \
        acc[ai][bj][m][n] = __builtin_amdgcn_mfma_f32_16x16x32_bf16(Bt[n][k], At[m][k], acc[ai][bj][m][n], 0, 0, 0); __builtin_amdgcn_s_setprio(0); } while (0)
#define PG8_WAIT_V(n) asm volatile("s_waitcnt vmcnt(" #n ")" ::: "memory")
#define PG8_WAIT_L(n) asm volatile("s_waitcnt lgkmcnt(" #n ")" ::: "memory")
#define PG8_BAR __builtin_amdgcn_s_barrier()
#define PG8_SCHED __builtin_amdgcn_sched_barrier(0)
    Unit cur, nxt; int ui = 0;
    if (!S.next(0, cur)) return;
    f32x4 acc[2][2][4][2];
#pragma unroll
    for (int a = 0; a < 2; ++a)
#pragma unroll
        for (int b = 0; b < 2; ++b)
#pragma unroll
            for (int m = 0; m < 4; ++m)
#pragma unroll
                for (int n = 0; n < 2; ++n) acc[a][b][m][n] = (f32x4){0.f, 0.f, 0.f, 0.f};
    bf16x8 At[4][2], B0[2][2], B1[2][2];
    const char* cA = (const char*)g.A + (size_t)cur.pm * tstep; const char* cB = (const char*)g.Bt + (size_t)cur.pn * tstep;
    S.a_ready(cur);
    if constexpr (SP2) {
        PG8_STAGE(PG8_SB(0, 0), cB, voffB); PG8_STAGE(PG8_SB(0, 1), cB + hstep, voffB); PG8_STAGE(PG8_SA(0, 0), cA, voffA); PG8_STAGE(PG8_SA(0, 1), cA + hstep, voffA);
        if (wr == 1) PG8_BAR;
        PG8_WAIT_V(2); PG8_BAR;
        PG8_STAGE(PG8_SB(1, 0), cB + kstep, voffB); PG8_STAGE(PG8_SA(1, 0), cA + kstep, voffA); PG8_STAGE(PG8_SB(1, 1), cB + hstep + kstep, voffB);
        PG8_WAIT_V(6); PG8_BAR;
    } else {
        PG8_STAGE(PG8_SB(0, 0), cB, voffB); PG8_STAGE(PG8_SA(0, 0), cA, voffA); PG8_STAGE(PG8_SB(0, 1), cB + hstep, voffB); PG8_STAGE(PG8_SA(0, 1), cA + hstep, voffA);
        if (wr == 1) PG8_BAR;
        PG8_WAIT_V(4); PG8_BAR;
        PG8_STAGE(PG8_SB(1, 0), cB + kstep, voffB); PG8_STAGE(PG8_SA(1, 0), cA + kstep, voffA); PG8_STAGE(PG8_SB(1, 1), cB + hstep + kstep, voffB);
        PG8_WAIT_V(6); PG8_BAR;
    }
    for (;;) {
        const bool has_next = S.next(ui + 1, nxt);
        const char* nA = has_next ? (const char*)g.A + (size_t)nxt.pm * tstep : cA; const char* nB = has_next ? (const char*)g.Bt + (size_t)nxt.pn * tstep : cB;
        for (int t = 0; t < nt; t += 2) {
            const bool last = (t == nt - 2);
            const char* a1 = cA + (size_t)(t + 1) * kstep;
            const char* a2 = last ? nA : cA + (size_t)(t + 2) * kstep; const char* b2 = last ? nB : cB + (size_t)(t + 2) * kstep;
            const char* a3 = a2 + kstep; const char* b3 = b2 + kstep;
            if (last && has_next) S.a_ready(nxt);
            if constexpr (SP2) {
            PG8_LDB(B0, 0, 0); PG8_LDB(B1, 0, 1); PG8_SCHED; PG8_LDA(At, 0, 0); PG8_STAGE(PG8_SA(1, 1), a1 + hstep, voffA);
            PG8_WAIT_V(8); PG8_WAIT_L(0); PG8_BAR; PG8_MMA(0, 0, At, B0); PG8_MMA(0, 1, At, B1); PG8_BAR; PG8_SCHED;
            PG8_LDA(At, 0, 1); PG8_STAGE(PG8_SB(0, 0), b2, voffB); PG8_STAGE(PG8_SB(0, 1), b2 + hstep, voffB); PG8_STAGE(PG8_SA(0, 0), a2, voffA);
            PG8_WAIT_V(8); PG8_WAIT_L(0); PG8_BAR; PG8_MMA(1, 0, At, B0); PG8_MMA(1, 1, At, B1); PG8_BAR; PG8_SCHED;
            PG8_LDB(B0, 1, 0); PG8_LDB(B1, 1, 1); PG8_SCHED; PG8_LDA(At, 1, 0); PG8_STAGE(PG8_SA(0, 1), a2 + hstep, voffA);
            PG8_WAIT_V(8); PG8_WAIT_L(0); PG8_BAR; PG8_MMA(0, 0, At, B0); PG8_MMA(0, 1, At, B1); PG8_BAR; PG8_SCHED;
            PG8_LDA(At, 1, 1); PG8_STAGE(PG8_SB(1, 0), b3, voffB); PG8_STAGE(PG8_SB(1, 1), b3 + hstep, voffB); PG8_STAGE(PG8_SA(1, 0), a3, voffA);
            PG8_WAIT_V(8); PG8_WAIT_L(0); PG8_BAR; PG8_MMA(1, 0, At, B0); PG8_MMA(1, 1, At, B1); PG8_BAR; PG8_SCHED;
            } else {
            PG8_LDB(B0, 0, 0); PG8_SCHED; PG8_LDA(At, 0, 0); PG8_STAGE(PG8_SA(1, 1), a1 + hstep, voffA);
            PG8_WAIT_L(8); PG8_BAR; PG8_WAIT_L(0); PG8_MMA(0, 0, At, B0); PG8_BAR; PG8_SCHED;
            PG8_LDB(B1, 0, 1); PG8_STAGE(PG8_SB(0, 0), b2, voffB);
            PG8_BAR; PG8_WAIT_L(0); PG8_MMA(0, 1, At, B1); PG8_BAR;
            PG8_LDA(At, 0, 1); PG8_STAGE(PG8_SA(0, 0), a2, voffA);
            PG8_BAR; PG8_WAIT_L(0); PG8_MMA(1, 0, At, B0); PG8_BAR; PG8_SCHED;
            PG8_STAGE(PG8_SB(0, 1), b2 + hstep, voffB);
            PG8_WAIT_V(6); PG8_BAR; PG8_MMA(1, 1, At, B1); PG8_BAR;
            PG8_LDB(B0, 1, 0); PG8_SCHED; PG8_LDA(At, 1, 0); PG8_STAGE(PG8_SA(0, 1), a2 + hstep, voffA);
            PG8_WAIT_L(8); PG8_BAR; PG8_WAIT_L(0); PG8_MMA(0, 0, At, B0); PG8_BAR; PG8_SCHED;
            PG8_LDB(B1, 1, 1); PG8_STAGE(PG8_SB(1, 0), b3, voffB);
            PG8_BAR; PG8_WAIT_L(0); PG8_MMA(0, 1, At, B1); PG8_BAR;
            PG8_LDA(At, 1, 1); PG8_STAGE(PG8_SA(1, 0), a3, voffA);
            PG8_BAR; PG8_WAIT_L(0); PG8_MMA(1, 0, At, B0); PG8_BAR; PG8_SCHED;
            PG8_STAGE(PG8_SB(1, 1), b3 + hstep, voffB);
            PG8_WAIT_V(6); PG8_BAR; PG8_MMA(1, 1, At, B1); PG8_BAR;
            }
        }
        if constexpr (ALIGN_EPI) { if (wr == 0) PG8_BAR; }
        if constexpr (!Epi::AFTER_DRAIN) { E(acc, cur, wr, wc, fr, fq); S.done(cur); }
        if (!has_next) break;
#pragma unroll
        for (int a = 0; a < 2; ++a)
#pragma unroll
            for (int b = 0; b < 2; ++b)
#pragma unroll
                for (int m = 0; m < 4; ++m)
#pragma unroll
                    for (int n = 0; n < 2; ++n) acc[a][b][m][n] = (f32x4){0.f, 0.f, 0.f, 0.f};
        cur = nxt; cA = nA; cB = nB; ++ui;
        if constexpr (ALIGN_EPI) { if (wr == 1) PG8_BAR; }
    }
    PG8_WAIT_V(0);
    if constexpr (!ALIGN_EPI) { if (wr == 0) PG8_BAR; }
    PG8_BAR;
    if constexpr (Epi::AFTER_DRAIN) { E.fused(acc, cur, wr, wc, fr, fq, lds, wid, lane); S.done(cur); }
#undef PG8_SA
#undef PG8_SB
#undef PG8_STAGE
#undef PG8_LDA
#undef PG8_LDB
#undef PG8_MMA
#undef PG8_WAIT_V
#undef PG8_WAIT_L
#undef PG8_BAR
#undef PG8_SCHED
}
}
using pg8::bf16_t; using pg8::bf16x8; using pg8::f32x4; using pg8::u32x4; using pg8::Unit; using pg8::cvt_pk_bf16;
#define LAS __attribute__((address_space(3)))
typedef unsigned u32x2 __attribute__((ext_vector_type(2)));

constexpr int MX = 16384, MT = 16640, DM = 1024, RGW = 1280, DFF = 2816, N1 = 6656;
constexpr float EPS = 1e-6f;
constexpr size_t MiB = (size_t)1 << 20;
constexpr size_t WS_WIN = 1 * MiB;
constexpr size_t WS_WPA = 18 * MiB;
constexpr size_t WS_WPB = WS_WPA + 2621440;
constexpr size_t WS_WOUT = WS_WPB + 2 * MiB;
constexpr size_t WS_WFI = WS_WOUT + 2 * MiB;
constexpr size_t WS_WFD = WS_WFI + 11 * MiB;
constexpr size_t WS_MISC = 41 * MiB;
constexpr size_t WS_GFRAG = WS_MISC;
constexpr size_t WS_RGAGG = WS_MISC + 512 * 1024;
constexpr size_t WS_RGAGM = WS_MISC + 1792 * 1024;
constexpr size_t WS_HGD = WS_MISC + 1856 * 1024;
constexpr size_t WS_HGSM = WS_MISC + 2112 * 1024;
constexpr size_t WS_XN = 44 * MiB;
constexpr size_t WS_AX = WS_XN + (size_t)MT * DM * 2;
constexpr size_t WS_AG = WS_AX + (size_t)MT * RGW * 2;
constexpr size_t WS_Q = WS_AG + (size_t)MX * RGW * 2;
constexpr size_t WS_F = WS_Q + (size_t)MX * DM * 2;
constexpr size_t WS_V = WS_F + (size_t)MT * DM * 2;
static_assert(WS_V + (size_t)MT * DM * 2 <= 256 * MiB, "ws map");
static_assert(WS_AG + (size_t)MX * DFF * 2 <= WS_V, "ACT overlay");
constexpr size_t WS_GA = WS_AX, WS_GB = WS_V, WS_T1 = WS_Q, WS_MG = WS_F;
constexpr size_t OUT_G = 0, OUT_HGS = 32 * MiB;
constexpr int LDS_BYTES = 147456;

struct Args { const float* in[20]; float* out; unsigned char* ws; int ph_lo, ph_hi; };

__device__ __forceinline__ float bf2f(unsigned short b) { return __uint_as_float(((unsigned)b) << 16); }
__device__ __forceinline__ float bflo(unsigned w) { return __uint_as_float(w << 16); }
__device__ __forceinline__ float bfhi(unsigned w) { return __uint_as_float(w & 0xffff0000u); }
__device__ __forceinline__ unsigned short f2bf(float f) { unsigned u = __float_as_uint(f); return (unsigned short)((u + 0x7fffu + ((u >> 16) & 1u)) >> 16); }
__device__ __forceinline__ float sigm(float x) { return __builtin_amdgcn_rcpf(1.f + __expf(-x)); }
__device__ __forceinline__ float wave_sum(float v) {
#pragma unroll
    for (int o = 1; o < 64; o <<= 1) v += __shfl_xor(v, o);
    return v;
}
#define LDS_WAIT() asm volatile("s_waitcnt lgkmcnt(0)" ::: "memory")
__device__ __forceinline__ int tok_row(int b, int s) { return s >= 0 ? b * 8192 + s : (s >= -16 ? 16400 + s : -1); }

__device__ __forceinline__ void transpose_item(const float* W, int K, int N, bf16_t* WT, int dst_row0, int k0, int n0, LAS float* scr, int lane) {
#pragma unroll 8
    for (int i = 0; i < 32; ++i) { const int kk = 2 * i + (lane >> 5); scr[kk * 33 + (lane & 31)] = W[(size_t)(k0 + kk) * N + n0 + (lane & 31)]; }
    LDS_WAIT();
    const int c = lane & 7;
#pragma unroll
    for (int j = 0; j < 4; ++j) { const int n = (lane >> 3) + 8 * j; const LAS float* s = scr + (8 * c) * 33 + n;
        u32x4 o; o.x = cvt_pk_bf16(s[0 * 33], s[1 * 33]); o.y = cvt_pk_bf16(s[2 * 33], s[3 * 33]); o.z = cvt_pk_bf16(s[4 * 33], s[5 * 33]); o.w = cvt_pk_bf16(s[6 * 33], s[7 * 33]);
        *(u32x4*)(WT + (size_t)(dst_row0 + n) * K + k0 + 8 * c) = o; }
    LDS_WAIT();
}
__device__ __forceinline__ void norm_row_bf16(const float* xrow, const float* g, bf16_t* orow, int lane) {
    f32x4 v[4]; float s = 0.f;
#pragma unroll
    for (int j = 0; j < 4; ++j) { v[j] = xrow ? ((const f32x4*)xrow)[lane + 64 * j] : (f32x4){0.f, 0.f, 0.f, 0.f}; s += (v[j].x * v[j].x + v[j].y * v[j].y) + (v[j].z * v[j].z + v[j].w * v[j].w); }
    const float rstd = rsqrtf(wave_sum(s) * (1.f / 1024.f) + EPS);
#pragma unroll
    for (int j = 0; j < 4; ++j) { const f32x4 gg = ((const f32x4*)g)[lane + 64 * j]; u32x2 o; o.x = cvt_pk_bf16(v[j].x * rstd * gg.x, v[j].y * rstd * gg.y); o.y = cvt_pk_bf16(v[j].z * rstd * gg.z, v[j].w * rstd * gg.w);
        ((u32x2*)orow)[lane + 64 * j] = o; }
}
__device__ __forceinline__ void p0_prologue(LAS unsigned char* lds, const Args& a) {
    const int tid = threadIdx.x, lane = tid & 63, wid = tid >> 6;
    LAS float* scr = (LAS float*)(lds + wid * 16384);
    const int gw = blockIdx.x * 8 + wid, NGW = gridDim.x * 8;
    unsigned char* ws = a.ws;
    for (int it = gw; it < 10240; it += NGW) {
        int r = it;
        if (r < 4352) { const int kb = r / 272, nb = r % 272; transpose_item(a.in[3], 1024, 8704, (bf16_t*)(ws + WS_WIN), 32 * nb, 64 * kb, 32 * nb, scr, lane); continue; } r -= 4352;
        if (r < 640) { const int kb = r / 32, nb = r % 32; transpose_item(a.in[13], 1280, 1024, (bf16_t*)(ws + WS_WPA), 32 * nb, 64 * kb, 32 * nb, scr, lane); continue; } r -= 640;
        if (r < 512) { const int kb = r / 32, nb = r % 32; transpose_item(a.in[14], 1024, 1024, (bf16_t*)(ws + WS_WPB), 32 * nb, 64 * kb, 32 * nb, scr, lane); continue; } r -= 512;
        if (r < 512) { const int kb = r / 32, nb = r % 32; transpose_item(a.in[15], 1024, 1024, (bf16_t*)(ws + WS_WOUT), 32 * nb, 64 * kb, 32 * nb, scr, lane); continue; } r -= 512;
        if (r < 2816) { const int kb = r / 176, nb = r % 176; const int n0 = 32 * nb; const int nn = n0 < 2816 ? n0 : n0 - 2816;
            const int dr = (nn >> 7) * 256 + (n0 < 2816 ? 0 : 128) + (nn & 127);
            transpose_item(a.in[17], 1024, 5632, (bf16_t*)(ws + WS_WFI), dr, 64 * kb, n0, scr, lane); continue; } r -= 2816;
        { const int kb = r / 32, nb = r % 32; transpose_item(a.in[18], 2816, 1024, (bf16_t*)(ws + WS_WFD), 32 * nb, 64 * kb, 32 * nb, scr, lane); }
    }
    for (int m = gw; m < MT; m += NGW) {
        const float* src = m < MX ? a.in[0] + (size_t)m * DM : (m < MX + 16 ? a.in[1] + (size_t)(m - MX) * DM : nullptr);
        norm_row_bf16(src, a.in[2], (bf16_t*)(ws + WS_XN) + (size_t)m * DM, lane);
    }
    for (int idx = blockIdx.x * 512 + tid; idx < 30720; idx += gridDim.x * 512) {
        const int l = idx & 63, f = idx >> 6, ks = f % 3, nt = (f / 3) % 5, n = (f / 15) % 16, g = f / 240, quad = l >> 4, col = l & 15;
        const float* W = (g ? a.in[8] : a.in[6]) + (size_t)n * 6400;
        float v[8];
#pragma unroll
        for (int j = 0; j < 8; ++j) { const int k = 32 * ks + 8 * quad + j; v[j] = k < 80 ? W[k * 80 + 16 * nt + col] : 0.f; }
        u32x4 o; o.x = cvt_pk_bf16(v[0], v[1]); o.y = cvt_pk_bf16(v[2], v[3]); o.z = cvt_pk_bf16(v[4], v[5]); o.w = cvt_pk_bf16(v[6], v[7]);
        ((u32x4*)(ws + WS_GFRAG))[idx] = o;
    }
}

template <int PASS>
__device__ __forceinline__ void rg_pass(LAS unsigned char* lds, const Args& a) {
    int tid_ = threadIdx.x; asm volatile("" : "+v"(tid_));
    const int tid = tid_, lane = tid & 63, wid = tid >> 6, quad = lane >> 4, col = lane & 15;
    const int g = blockIdx.x, n = g & 15, sc = (g >> 4) & 7, b = g >> 7;
    unsigned char* ws = a.ws;
    LAS u32x4* bfr = (LAS u32x4*)lds; LAS float* cw = (LAS float*)(lds + 30720); LAS float* cb = (LAS float*)(lds + 32256);
    { const u32x4* gf = (const u32x4*)(ws + WS_GFRAG);
      for (int i = tid; i < 1920; i += 512) { const int f = i >> 6, l = i & 63, gs = f / 15, r = f % 15; bfr[i] = gf[((gs * 16 + n) * 15 + r) * 64 + l]; }
      for (int i = tid; i < 384; i += 512) { const int j = i / 96, c = i % 96; cw[i] = c < 80 ? a.in[4][j * 1280 + 80 * n + c] : 0.f; }
      if (tid < 96) cb[tid] = tid < 80 ? a.in[5][80 * n + tid] : 0.f; }
    __syncthreads();
    float ba[5], bx[5], sp[5], h[5], ap[5];
#pragma unroll
    for (int nt = 0; nt < 5; ++nt) { const int c = 80 * n + 16 * nt + col; ba[nt] = a.in[7][c]; bx[nt] = a.in[9][c]; sp[nt] = 8.f * log1pf(__expf(-a.in[10][c])); h[nt] = 0.f; ap[nt] = 1.f; }
    const int c = 8 * sc + wid;
    float* agg = (float*)(ws + WS_RGAGG); float* aggm = (float*)(ws + WS_RGAGM);
    if (PASS == 2) {
#pragma unroll
        for (int nt = 0; nt < 5; ++nt) h[nt] = aggm[(n * 2 + 1) * 80 + 16 * nt + col];
        const float* ag = agg + (size_t)((b * 16 + n) * 64) * 160;
        for (int j = 0; j < c; ++j) {
#pragma unroll
            for (int nt = 0; nt < 5; ++nt) { const float A = ag[j * 160 + 16 * nt + col], U = ag[j * 160 + 80 + 16 * nt + col]; h[nt] = A * h[nt] + U; }
        }
    }
    bf16x8 idE, idO;
#pragma unroll
    for (int j = 0; j < 8; ++j) { idE[j] = (8 * quad + j == col) ? (short)0x3F80 : (short)0; idO[j] = (8 * quad + j == 16 + col) ? (short)0x3F80 : (short)0; }
    const bf16_t* AX = (const bf16_t*)(ws + WS_AX); bf16_t* AG = (bf16_t*)(ws + WS_AG);
    const int ntile = 8 + ((PASS == 1 && b == 0 && sc == 0 && wid == 0) ? 1 : 0);
    for (int it = 0; it < ntile; ++it) {
        if (PASS == 1 && it == 8) {
            if (quad == 0) {
#pragma unroll
                for (int nt = 0; nt < 5; ++nt) { agg[(size_t)((b * 16 + n) * 64 + c) * 160 + 16 * nt + col] = ap[nt]; agg[(size_t)((b * 16 + n) * 64 + c) * 160 + 80 + 16 * nt + col] = h[nt]; } }
#pragma unroll
            for (int nt = 0; nt < 5; ++nt) { h[nt] = 0.f; ap[nt] = 1.f; }
        }
        const int s0 = it < 8 ? 128 * c + 16 * it : -16;
        unsigned short gv[20];
        if (PASS == 2) {
#pragma unroll
            for (int nt = 0; nt < 5; ++nt)
#pragma unroll
                for (int r = 0; r < 4; ++r) gv[nt * 4 + r] = AG[(size_t)(b * 8192 + s0 + 4 * quad + r) * RGW + 80 * n + 16 * nt + col];
        }
        bf16x8 af[3];
        const int s = s0 + col;
#pragma unroll
        for (int ks = 0; ks < 3; ++ks) {
            const int ch = 32 * ks + 8 * quad;
            if (ch < 80) {
                const f32x4 b0 = *(const LAS f32x4*)(cb + ch), b1 = *(const LAS f32x4*)(cb + ch + 4);
                float xc[8] = {b0.x, b0.y, b0.z, b0.w, b1.x, b1.y, b1.z, b1.w};
                u32x4 wv[4];
#pragma unroll
                for (int j = 0; j < 4; ++j) { const int r = tok_row(b, s - 3 + j); wv[j] = *(const u32x4*)(AX + (size_t)(r < 0 ? 16384 : r) * RGW + 80 * n + ch); if (r < 0) wv[j] = (u32x4){0u, 0u, 0u, 0u}; }
#pragma unroll
                for (int j = 0; j < 4; ++j) {
                    const u32x4 w = wv[j];
                    const f32x4 w0 = *(const LAS f32x4*)(cw + j * 96 + ch), w1 = *(const LAS f32x4*)(cw + j * 96 + ch + 4);
                    xc[0] += w0.x * bflo(w.x); xc[1] += w0.y * bfhi(w.x); xc[2] += w0.z * bflo(w.y); xc[3] += w0.w * bfhi(w.y);
                    xc[4] += w1.x * bflo(w.z); xc[5] += w1.y * bfhi(w.z); xc[6] += w1.z * bflo(w.w); xc[7] += w1.w * bfhi(w.w);
                }
                u32x4 p; p.x = cvt_pk_bf16(xc[0], xc[1]); p.y = cvt_pk_bf16(xc[2], xc[3]); p.z = cvt_pk_bf16(xc[4], xc[5]); p.w = cvt_pk_bf16(xc[6], xc[7]);
                af[ks] = __builtin_bit_cast(bf16x8, p);
            } else af[ks] = (bf16x8){0, 0, 0, 0, 0, 0, 0, 0};
        }
#pragma unroll
        for (int nt = 0; nt < 5; ++nt) {
            f32x4 aR = {0.f, 0.f, 0.f, 0.f}, aI = {0.f, 0.f, 0.f, 0.f}, aX = {0.f, 0.f, 0.f, 0.f};
#pragma unroll
            for (int ks = 0; ks < 3; ++ks) {
                const bf16x8 bR = __builtin_bit_cast(bf16x8, bfr[(nt * 3 + ks) * 64 + lane]), bI = __builtin_bit_cast(bf16x8, bfr[((5 + nt) * 3 + ks) * 64 + lane]);
                aR = __builtin_amdgcn_mfma_f32_16x16x32_bf16(af[ks], bR, aR, 0, 0, 0);
                aI = __builtin_amdgcn_mfma_f32_16x16x32_bf16(af[ks], bI, aI, 0, 0, 0);
            }
            aX = __builtin_amdgcn_mfma_f32_16x16x32_bf16(af[nt >> 1], (nt & 1) ? idO : idE, aX, 0, 0, 0);
            float pa[4], ha[4];
#pragma unroll
            for (int r = 0; r < 4; ++r) {
                const float rr = sigm(aR[r] + ba[nt]), ii = sigm(aI[r] + bx[nt]);
                const float la = -rr * sp[nt], av = __expf(la), x2 = 2.f * la;
                const float om = x2 > -0.02f ? -x2 * (1.f + 0.5f * x2 * (1.f + x2 * (1.f / 3.f))) : 1.f - av * av;
                const float uu = sqrtf(om) * ii * aX[r];
                if (r == 0) { pa[0] = av; ha[0] = uu; } else { pa[r] = pa[r - 1] * av; ha[r] = av * ha[r - 1] + uu; }
            }
            float PA = 1.f, HA = 0.f;
#pragma unroll
            for (int j = 0; j < 3; ++j) { const float pj = __shfl(pa[3], col + 16 * j), hj = __shfl(ha[3], col + 16 * j); if (j < quad) { HA = pj * HA + hj; PA = pj * PA; } }
            const float hq = PA * h[nt] + HA;
            float o[4];
#pragma unroll
            for (int r = 0; r < 4; ++r) o[r] = pa[r] * hq + ha[r];
            h[nt] = __shfl(o[3], 48 + col);
            ap[nt] *= __shfl(pa[3] * PA, 48 + col);
            if (PASS == 2) {
#pragma unroll
                for (int r = 0; r < 4; ++r) AG[(size_t)(b * 8192 + s0 + 4 * quad + r) * RGW + 80 * n + 16 * nt + col] = f2bf(o[r] * bf2f(gv[nt * 4 + r]));
            }
        }
    }
    if (PASS == 1 && quad == 0) {
        float* dst = ntile == 9 ? aggm + (size_t)n * 160 : agg + (size_t)((b * 16 + n) * 64 + c) * 160;
#pragma unroll
        for (int nt = 0; nt < 5; ++nt) { dst[16 * nt + col] = ap[nt]; dst[80 + 16 * nt + col] = h[nt]; }
    }
    __syncthreads();
}

constexpr int HQE = 0, HKE = 17408, HKDT = 34816, HVT = 53248, HPB = 71680, HOB = 80896, HPART = 114688, HEM = 116736, HEB = 117248;
template <int PASS>
__device__ __forceinline__ void hg_pass(LAS unsigned char* lds, const Args& a) {
    int tid_ = threadIdx.x; asm volatile("" : "+v"(tid_));
    const int tid = tid_, lane = tid & 63, wid = tid >> 6, quad = lane >> 4, col = lane & 15;
    const int k = tid & 127, tq = tid >> 7;
    unsigned char* ws = a.ws;
    const bf16_t* Fb = (const bf16_t*)(ws + WS_F); const bf16_t* Vb = (const bf16_t*)(ws + WS_V); const bf16_t* Qb = (const bf16_t*)(ws + WS_Q);
    bf16_t* Gb = (bf16_t*)((unsigned char*)a.out + OUT_G);
    float* ST = (float*)((unsigned char*)a.out + OUT_HGS); float* STM = (float*)(ws + WS_HGSM); float* HD = (float*)(ws + WS_HGD);
    LAS float* PART = (LAS float*)(lds + HPART); LAS float* EM = (LAS float*)(lds + HEM); LAS float* EB = (LAS float*)(lds + HEB); LAS float* OB = (LAS float*)(lds + HOB);
    const int nunits = PASS == 0 ? 520 : 512;
    for (int u = blockIdx.x; u < nunits; u += gridDim.x) {
        const bool meta = u >= 512;
        const int hh = meta ? u - 512 : (u >> 5) & 7, b = meta ? 0 : u >> 8, j = u & 31, nchunk = meta ? 1 : 4;
        const float lbv = __builtin_amdgcn_rcpf(1.f + __expf(a.in[11][1024 + hh * 128 + k] - a.in[11][hh * 128 + k]));
        f32x4 S[8];
        if (PASS == 0) {
#pragma unroll
            for (int kb = 0; kb < 8; ++kb) S[kb] = (f32x4){0.f, 0.f, 0.f, 0.f};
        } else {
            const float* sp = ST + (size_t)u * 16384 + 16 * wid + col;
#pragma unroll
            for (int kb = 0; kb < 8; ++kb)
#pragma unroll
                for (int r = 0; r < 4; ++r) S[kb][r] = sp[(16 * kb + 4 * quad + r) * 128];
        }
        float btot = 0.f;
        for (int ci = 0; ci < nchunk; ++ci) {
            const int s0 = meta ? -64 : 256 * j + 64 * ci;
            float bc[16], kv[16]; unsigned short vr[16], fr16[16]; float qv[16];
#pragma unroll
            for (int i = 0; i < 16; ++i) {
                const int r = tok_row(b, s0 + 16 * tq + i), rc = r < 0 ? 16384 : r;
                fr16[i] = Fb[(size_t)rc * DM + hh * 128 + k]; vr[i] = Vb[(size_t)rc * DM + hh * 128 + k];
                if (PASS == 2) qv[i] = bf2f(Qb[(size_t)rc * DM + hh * 128 + k]);
            }
            float csum = 0.f;
#pragma unroll
            for (int i = 0; i < 16; ++i) {
                const bool valid = !meta || tq == 3;
                float fl = bf2f(fr16[i]); fl = fminf(fmaxf(fl, -30.f), 30.f);
                const float e = __expf(-fl), sg = __builtin_amdgcn_rcpf(1.f + e);
                csum += valid ? __logf(lbv + (1.f - lbv) * sg) : 0.f; kv[i] = valid ? (1.f - lbv) * e * sg : 0.f;
                if (!valid) vr[i] = 0;
                bc[i] = csum;
            }
            PART[tq * 128 + k] = csum;
            __syncthreads();
            const float p0 = PART[k], p1 = PART[128 + k], p2 = PART[256 + k], p3 = PART[384 + k];
            const float off = tq == 0 ? 0.f : (tq == 1 ? p0 : (tq == 2 ? p0 + p1 : p0 + p1 + p2));
            const float blast = (p0 + p1) + (p2 + p3), mid = p0 + p1;
            btot += blast;
            {
                unsigned kw[8], vw[8];
#pragma unroll
                for (int i = 0; i < 8; ++i) {
                    const float e0 = __expf(blast - (off + bc[2 * i])), e1 = __expf(blast - (off + bc[2 * i + 1]));
                    kw[i] = cvt_pk_bf16(kv[2 * i] * e0, kv[2 * i + 1] * e1); vw[i] = (unsigned)vr[2 * i] | ((unsigned)vr[2 * i + 1] << 16);
                }
                LAS u32x4* kd = (LAS u32x4*)(lds + HKDT + k * 144 + tq * 32); kd[0] = (u32x4){kw[0], kw[1], kw[2], kw[3]}; kd[1] = (u32x4){kw[4], kw[5], kw[6], kw[7]};
                LAS u32x4* vt = (LAS u32x4*)(lds + HVT + k * 144 + tq * 32); vt[0] = (u32x4){vw[0], vw[1], vw[2], vw[3]}; vt[1] = (u32x4){vw[4], vw[5], vw[6], vw[7]};
            }
            if (PASS == 2) {
#pragma unroll
                for (int i = 0; i < 16; ++i) {
                    const float d = off + bc[i] - mid; const int t = 16 * tq + i;
                    *(LAS bf16_t*)(lds + HQE + t * 272 + k * 2) = f2bf(qv[i] * __expf(fminf(d, 80.f)));
                    *(LAS bf16_t*)(lds + HKE + t * 272 + k * 2) = f2bf(kv[i] * __expf(fminf(-d, 80.f)));
                }
            }
            if (tq == 0) { EB[k] = __expf(blast); EM[k] = __expf(mid); }
            __syncthreads();
            bf16x8 vf[2];
#pragma unroll
            for (int ks = 0; ks < 2; ++ks) vf[ks] = *(const LAS bf16x8*)(lds + HVT + (16 * wid + col) * 144 + ks * 64 + quad * 16);
            if (PASS == 2) {
                {
                    const int I = wid >> 1, sh = wid & 1;
                    f32x4 p0a = {0.f, 0.f, 0.f, 0.f}, p1a = {0.f, 0.f, 0.f, 0.f};
#pragma unroll
                    for (int ks = 0; ks < 4; ++ks) {
                        const bf16x8 qa = *(const LAS bf16x8*)(lds + HQE + (16 * I + col) * 272 + ks * 64 + quad * 16);
                        const bf16x8 k0 = *(const LAS bf16x8*)(lds + HKE + (32 * sh + col) * 272 + ks * 64 + quad * 16);
                        const bf16x8 k1 = *(const LAS bf16x8*)(lds + HKE + (32 * sh + 16 + col) * 272 + ks * 64 + quad * 16);
                        p0a = __builtin_amdgcn_mfma_f32_16x16x32_bf16(qa, k0, p0a, 0, 0, 0);
                        p1a = __builtin_amdgcn_mfma_f32_16x16x32_bf16(qa, k1, p1a, 0, 0, 0);
                    }
#pragma unroll
                    for (int r = 0; r < 4; ++r) { const int t = 16 * I + 4 * quad + r, sa = 32 * sh + col;
                        *(LAS bf16_t*)(lds + HPB + t * 144 + sa * 2) = sa <= t ? f2bf(p0a[r]) : (bf16_t)0;
                        *(LAS bf16_t*)(lds + HPB + t * 144 + (sa + 16) * 2) = sa + 16 <= t ? f2bf(p1a[r]) : (bf16_t)0; }
                }
                bf16x8 sf[4];
#pragma unroll
                for (int ks = 0; ks < 4; ++ks) {
                    const f32x4 ea = *(const LAS f32x4*)(EM + 32 * ks + 4 * quad), eb2 = *(const LAS f32x4*)(EM + 32 * ks + 16 + 4 * quad);
                    const f32x4 x0 = S[2 * ks] * ea, x1 = S[2 * ks + 1] * eb2;
                    u32x4 p; p.x = cvt_pk_bf16(x0.x, x0.y); p.y = cvt_pk_bf16(x0.z, x0.w); p.z = cvt_pk_bf16(x1.x, x1.y); p.w = cvt_pk_bf16(x1.z, x1.w);
                    sf[ks] = __builtin_bit_cast(bf16x8, p);
                }
                __syncthreads();
#pragma unroll
                for (int tt = 0; tt < 4; ++tt) {
                    f32x4 acc = {0.f, 0.f, 0.f, 0.f};
#pragma unroll
                    for (int ks = 0; ks < 2; ++ks) { const bf16x8 pa = *(const LAS bf16x8*)(lds + HPB + (16 * tt + col) * 144 + ks * 64 + quad * 16); acc = __builtin_amdgcn_mfma_f32_16x16x32_bf16(pa, vf[ks], acc, 0, 0, 0); }
#pragma unroll
                    for (int ks = 0; ks < 4; ++ks) {
                        const u32x2 lo = *(const LAS u32x2*)(lds + HQE + (16 * tt + col) * 272 + (32 * ks + 4 * quad) * 2), hi = *(const LAS u32x2*)(lds + HQE + (16 * tt + col) * 272 + (32 * ks + 16 + 4 * quad) * 2);
                        const u32x4 qq = {lo.x, lo.y, hi.x, hi.y};
                        acc = __builtin_amdgcn_mfma_f32_16x16x32_bf16(__builtin_bit_cast(bf16x8, qq), sf[ks], acc, 0, 0, 0);
                    }
#pragma unroll
                    for (int r = 0; r < 4; ++r) OB[(16 * tt + 4 * quad + r) * 132 + 16 * wid + col] = acc[r];
                }
            }
#pragma unroll
            for (int kb = 0; kb < 8; ++kb) {
                const f32x4 e4 = *(const LAS f32x4*)(EB + 16 * kb + 4 * quad);
                f32x4 sacc = S[kb] * e4;
#pragma unroll
                for (int ks = 0; ks < 2; ++ks) { const bf16x8 ka = *(const LAS bf16x8*)(lds + HKDT + (16 * kb + col) * 144 + ks * 64 + quad * 16); sacc = __builtin_amdgcn_mfma_f32_16x16x32_bf16(ka, vf[ks], sacc, 0, 0, 0); }
                S[kb] = sacc;
            }
            __syncthreads();
            if (PASS == 2) {
                const int t = tid >> 3, vs = (tid & 7) * 16;
                float o[16]; float ss = 0.f;
#pragma unroll
                for (int i = 0; i < 4; ++i) { const f32x4 x = *(const LAS f32x4*)(OB + t * 132 + vs + 4 * i); o[4 * i] = x.x; o[4 * i + 1] = x.y; o[4 * i + 2] = x.z; o[4 * i + 3] = x.w; ss += (x.x * x.x + x.y * x.y) + (x.z * x.z + x.w * x.w); }
                ss += __shfl_xor(ss, 1); ss += __shfl_xor(ss, 2); ss += __shfl_xor(ss, 4);
                const float rstd = rsqrtf(ss * (1.f / 128.f) + EPS);
                u32x4* gp = (u32x4*)(Gb + (size_t)(b * 8192 + s0 + t) * DM + hh * 128 + vs);
                const float* gn = a.in[12] + vs;
#pragma unroll
                for (int hf = 0; hf < 2; ++hf) {
                    const u32x4 gw = gp[hf]; u32x4 ow;
                    const unsigned gws[4] = {gw.x, gw.y, gw.z, gw.w}; unsigned ows[4];
#pragma unroll
                    for (int i = 0; i < 4; ++i) { const int e = 8 * hf + 2 * i; ows[i] = cvt_pk_bf16(o[e] * rstd * gn[e] * bflo(gws[i]), o[e + 1] * rstd * gn[e + 1] * bfhi(gws[i])); }
                    ow.x = ows[0]; ow.y = ows[1]; ow.z = ows[2]; ow.w = ows[3]; gp[hf] = ow;
                }
            }
        }
        if (PASS == 0) {
            float* sp = (meta ? STM + (size_t)hh * 16384 : ST + (size_t)u * 16384) + 16 * wid + col;
#pragma unroll
            for (int kb = 0; kb < 8; ++kb)
#pragma unroll
                for (int r = 0; r < 4; ++r) sp[(16 * kb + 4 * quad + r) * 128] = S[kb][r];
            if (!meta && tq == 0) HD[u * 128 + k] = __expf(btot);
        }
        __syncthreads();
    }
}
__device__ __forceinline__ void hg_pass_b(const Args& a) {
    float* ST = (float*)((unsigned char*)a.out + OUT_HGS); const float* STM = (const float*)(a.ws + WS_HGSM); const float* HD = (const float*)(a.ws + WS_HGD);
    for (int e = blockIdx.x * 512 + threadIdx.x; e < 16 * 16384; e += gridDim.x * 512) {
        const int bh = e >> 14, kv = e & 16383, k = kv >> 7, hh = bh & 7;
        float s = STM[hh * 16384 + kv];
#pragma unroll 8
        for (int j = 0; j < 32; ++j) { const int u = bh * 32 + j; const float d = ST[(size_t)u * 16384 + kv]; ST[(size_t)u * 16384 + kv] = s; s = HD[u * 128 + k] * s + d; }
    }
}


#ifndef RG_NAIVE
#define RG_NAIVE 0
#endif
#ifndef HG_NAIVE
#define HG_NAIVE 0
#endif
__device__ __forceinline__ void rg_naive(LAS unsigned char* lds, const Args& a) {
    if (blockIdx.x >= 32) return;
    const int b = blockIdx.x >> 4, n = blockIdx.x & 15, e = threadIdx.x, c = 80 * n + (e < 80 ? e : 0);
    LAS float* xs = (LAS float*)lds;
    const bf16_t* AX = (const bf16_t*)(a.ws + WS_AX); bf16_t* AG = (bf16_t*)(a.ws + WS_AG);
    float wa[80], wx[80];
#pragma unroll
    for (int d = 0; d < 80; ++d) { wa[d] = a.in[6][(size_t)n * 6400 + d * 80 + (e < 80 ? e : 0)]; wx[d] = a.in[8][(size_t)n * 6400 + d * 80 + (e < 80 ? e : 0)]; }
    const float ba = a.in[7][c], bx = a.in[9][c], sp = 8.f * log1pf(expf(-a.in[10][c])), cb = a.in[5][c];
    const float c0 = a.in[4][c], c1 = a.in[4][1280 + c], c2 = a.in[4][2560 + c], c3 = a.in[4][3840 + c];
    float h = 0.f, x0 = 0.f, x1 = 0.f, x2 = 0.f;
    for (int s = -16; s < 8192; ++s) {
        const float x3 = bf2f(AX[(size_t)tok_row(b, s) * RGW + c]);
        const float xc = cb + c0 * x0 + c1 * x1 + c2 * x2 + c3 * x3;
        x0 = x1; x1 = x2; x2 = x3;
        LAS float* xb = xs + (s & 1) * 80;
        if (e < 80) xb[e] = xc;
        __syncthreads();
        float r = ba, ii = bx;
#pragma unroll
        for (int d = 0; d < 80; ++d) { const float xv = xb[d]; r += xv * wa[d]; ii += xv * wx[d]; }
        const float la = -sp / (1.f + expf(-r)), av = expf(la), uu = sqrtf(-expm1f(2.f * la)) * xc / (1.f + expf(-ii));
        h = av * h + uu;
        if (s >= 0 && e < 80) { bf16_t* p = AG + (size_t)(b * 8192 + s) * RGW + c; *p = f2bf(h * bf2f(*p)); }
    }
    __syncthreads();
}
__device__ __forceinline__ void hg_naive(LAS unsigned char* lds, const Args& a) {
    if (blockIdx.x >= 16) return;
    const int b = blockIdx.x >> 3, hh = blockIdx.x & 7, v = threadIdx.x & 127; const bool act = threadIdx.x < 128;
    LAS float* fg = (LAS float*)lds; LAS float* kk = fg + 256; LAS float* qq = fg + 512; LAS float* red = fg + 768;
    const bf16_t* Fb = (const bf16_t*)(a.ws + WS_F); const bf16_t* Vb = (const bf16_t*)(a.ws + WS_V); const bf16_t* Qb = (const bf16_t*)(a.ws + WS_Q);
    bf16_t* Gb = (bf16_t*)((unsigned char*)a.out + OUT_G);
    const float lbv = 1.f / (1.f + expf(a.in[11][1024 + hh * 128 + v] - a.in[11][hh * 128 + v])), gn = a.in[12][v];
    float S[128];
#pragma unroll
    for (int k = 0; k < 128; ++k) S[k] = 0.f;
    for (int s = -16; s < 8192; ++s) {
        const int row = tok_row(b, s), par = (s & 1) * 128;
        const float fl = bf2f(Fb[(size_t)row * DM + hh * 128 + v]), sg = 1.f / (1.f + expf(-fl));
        const float vv = bf2f(Vb[(size_t)row * DM + hh * 128 + v]);
        if (act) { fg[par + v] = lbv + (1.f - lbv) * sg; kk[par + v] = (1.f - lbv) / (1.f + expf(fl)); qq[par + v] = s >= 0 ? bf2f(Qb[(size_t)row * DM + hh * 128 + v]) : 0.f; }
        __syncthreads();
        float o = 0.f;
#pragma unroll
        for (int k = 0; k < 128; ++k) { S[k] = fg[par + k] * S[k] + kk[par + k] * vv; o += S[k] * qq[par + k]; }
        const float ss = wave_sum(o * o);
        if ((threadIdx.x & 63) == 0 && act) red[(s & 1) * 2 + (threadIdx.x >> 6)] = ss;
        __syncthreads();
        if (s >= 0 && act) { const float tot = red[(s & 1) * 2] + red[(s & 1) * 2 + 1]; bf16_t* p = Gb + (size_t)(b * 8192 + s) * DM + hh * 128 + v; *p = f2bf(o * rsqrtf(tot * (1.f / 128.f) + EPS) * gn * bf2f(*p)); }
    }
    __syncthreads();
}

__device__ __forceinline__ u32x4 pack8(const f32x4& v0, const f32x4& v1) { u32x4 w; w.x = cvt_pk_bf16(v0[0], v0[1]); w.y = cvt_pk_bf16(v0[2], v0[3]); w.z = cvt_pk_bf16(v1[0], v1[1]); w.w = cvt_pk_bf16(v1[2], v1[3]); return w; }
struct EpiP1 {
    static constexpr bool PERM = true, AFTER_DRAIN = false;
    unsigned char* wsb; unsigned char* outb; int pn_off;
    __device__ __forceinline__ void operator()(const f32x4 (&acc)[2][2][4][2], const Unit& u, int wr, int wc, int fr, int fq) const {
        const int pn = u.pn + pn_off;
        const int seg = pn < 5 ? 0 : (pn < 10 ? 1 : (pn < 14 ? 2 : (pn < 18 ? 3 : (pn < 22 ? 4 : (pn < 26 ? 5 : (pn < 30 ? 6 : 7))))));
        const int ct = pn - (seg == 0 ? 0 : (seg == 1 ? 5 : (seg == 2 ? 10 : (seg == 3 ? 14 : (seg == 4 ? 18 : (seg == 5 ? 22 : (seg == 6 ? 26 : 30)))))));
        const int ld = seg < 2 ? RGW : DM, act = seg == 1 ? 1 : ((seg == 2 || seg == 5) ? 2 : (seg >= 6 ? 3 : 0));
        const size_t boff = seg == 0 ? WS_AX : (seg == 1 ? WS_AG : (seg == 2 ? WS_Q : (seg == 3 ? WS_F : (seg == 4 ? WS_V : (seg == 5 ? OUT_G : (seg == 6 ? WS_GA : WS_GB))))));
        bf16_t* base = (bf16_t*)((seg == 5 ? outb : wsb) + boff);
        if (act != 0 && u.pm >= 64) return;
        const float al = act == 1 ? 1.5957691216f : 1.f, be = act == 1 ? 0.0713548163f : 0.f;
        const int row0 = u.pm * 256 + wr * 64 + fr, col0 = ct * 256 + wc * 32 + 8 * fq;
#pragma unroll
        for (int ai = 0; ai < 2; ++ai)
#pragma unroll
            for (int m = 0; m < 4; ++m) { bf16_t* rowp = base + (size_t)(row0 + ai * 128 + m * 16) * ld + col0;
#pragma unroll
                for (int bj = 0; bj < 2; ++bj) { f32x4 v0 = acc[ai][bj][m][0], v1 = acc[ai][bj][m][1];
                    if (act) {
#pragma unroll
                        for (int i = 0; i < 4; ++i) { const float x = v0[i], y = v1[i]; const float sx = sigm(x * (al + be * x * x)), sy = sigm(y * (al + be * y * y)); v0[i] = act == 3 ? sx : x * sx; v1[i] = act == 3 ? sy : y * sy; } }
                    *(u32x4*)(rowp + bj * 128) = pack8(v0, v1); } }
    }
};
struct EpiGates {
    static constexpr bool PERM = true, AFTER_DRAIN = false;
    bf16_t *GA, *GB;
    __device__ __forceinline__ void operator()(const f32x4 (&acc)[2][2][4][2], const Unit& u, int wr, int wc, int fr, int fq) const {
        bf16_t* base = u.pn < 4 ? GA : GB; const int ct = u.pn & 3;
        const int row0 = u.pm * 256 + wr * 64 + fr, col0 = ct * 256 + wc * 32 + 8 * fq;
#pragma unroll
        for (int ai = 0; ai < 2; ++ai)
#pragma unroll
            for (int m = 0; m < 4; ++m) { bf16_t* rowp = base + (size_t)(row0 + ai * 128 + m * 16) * DM + col0;
#pragma unroll
                for (int bj = 0; bj < 2; ++bj) { f32x4 v0 = acc[ai][bj][m][0], v1 = acc[ai][bj][m][1];
#pragma unroll
                    for (int i = 0; i < 4; ++i) { v0[i] = sigm(v0[i]); v1[i] = sigm(v1[i]); }
                    *(u32x4*)(rowp + bj * 128) = pack8(v0, v1); } }
    }
};
#ifndef ZERO_A
#define ZERO_A 0
#endif
#ifndef ZERO_B
#define ZERO_B 0
#endif
template <int MODE> struct EpiMerge {
    static constexpr bool PERM = true, AFTER_DRAIN = false;
    const bf16_t* GT; const bf16_t* T1; bf16_t* O;
    __device__ __forceinline__ void operator()(const f32x4 (&acc)[2][2][4][2], const Unit& u, int wr, int wc, int fr, int fq) const {
        const int row0 = u.pm * 256 + wr * 64 + fr, col0 = u.pn * 256 + wc * 32 + 8 * fq;
#pragma unroll
        for (int ai = 0; ai < 2; ++ai)
#pragma unroll
            for (int m = 0; m < 4; ++m) { const size_t off = (size_t)(row0 + ai * 128 + m * 16) * DM + col0;
#pragma unroll
                for (int bj = 0; bj < 2; ++bj) { f32x4 v0 = acc[ai][bj][m][0], v1 = acc[ai][bj][m][1];
                    const u32x4 gw = *(const u32x4*)(GT + off + bj * 128);
                    v0[0] *= bflo(gw.x); v0[1] *= bfhi(gw.x); v0[2] *= bflo(gw.y); v0[3] *= bfhi(gw.y); v1[0] *= bflo(gw.z); v1[1] *= bfhi(gw.z); v1[2] *= bflo(gw.w); v1[3] *= bfhi(gw.w);
                    if ((MODE == 0 && ZERO_A) || (MODE == 1 && ZERO_B)) { v0 = (f32x4){0.f, 0.f, 0.f, 0.f}; v1 = v0; }
                    if (MODE == 1) { const u32x4 tw = *(const u32x4*)(T1 + off + bj * 128);
                        v0[0] += bflo(tw.x); v0[1] += bfhi(tw.x); v0[2] += bflo(tw.y); v0[3] += bfhi(tw.y); v1[0] += bflo(tw.z); v1[1] += bfhi(tw.z); v1[2] += bflo(tw.w); v1[3] += bfhi(tw.w); }
                    *(u32x4*)(O + off + bj * 128) = pack8(v0, v1); } }
    }
};
struct EpiRes {
    static constexpr bool PERM = false, AFTER_DRAIN = false;
    const float* base; float* out;
    __device__ __forceinline__ void operator()(const f32x4 (&acc)[2][2][4][2], const Unit& u, int wr, int wc, int fr, int fq) const {
        const int row0 = u.pm * 256 + wr * 64 + fr, col0 = u.pn * 256 + wc * 32 + 4 * fq;
#pragma unroll
        for (int ai = 0; ai < 2; ++ai)
#pragma unroll
            for (int m = 0; m < 4; ++m) { const size_t off = (size_t)(row0 + ai * 128 + m * 16) * DM + col0;
#pragma unroll
                for (int bj = 0; bj < 2; ++bj)
#pragma unroll
                    for (int n = 0; n < 2; ++n) { const f32x4 bs = *(const f32x4*)(base + off + bj * 128 + n * 16); *(f32x4*)(out + off + bj * 128 + n * 16) = bs + acc[ai][bj][m][n]; } }
    }
};
struct EpiFfn {
    static constexpr bool PERM = true, AFTER_DRAIN = false;
    bf16_t* O;
    __device__ __forceinline__ void operator()(const f32x4 (&acc)[2][2][4][2], const Unit& u, int wr, int wc, int fr, int fq) const {
        const int row0 = u.pm * 256 + wr * 64 + fr, col0 = u.pn * 128 + wc * 32 + 8 * fq;
#pragma unroll
        for (int ai = 0; ai < 2; ++ai)
#pragma unroll
            for (int m = 0; m < 4; ++m) { f32x4 v0, v1;
#pragma unroll
                for (int i = 0; i < 4; ++i) { const float g0 = acc[ai][0][m][0][i], g1 = acc[ai][0][m][1][i]; v0[i] = g0 * sigm(g0) * acc[ai][1][m][0][i]; v1[i] = g1 * sigm(g1) * acc[ai][1][m][1][i]; }
                *(u32x4*)(O + (size_t)(row0 + ai * 128 + m * 16) * DFF + col0) = pack8(v0, v1); }
    }
};


#ifndef SELFCHECK
#define SELFCHECK 0
#endif
constexpr size_t WS_FLAGS = 512 * 1024;
__device__ __forceinline__ unsigned hash32(unsigned x) { x ^= x >> 16; x *= 0x7feb352du; x ^= x >> 15; x *= 0x846ca68bu; x ^= x >> 16; return x; }
__device__ __forceinline__ float dot_bf_w(const bf16_t* arow, const float* W, int K, int N, int col, int lane) {
    float s = 0.f; for (int k = lane; k < K; k += 64) s += bf2f(arow[k]) * W[(size_t)k * N + col]; return wave_sum(s);
}
__device__ __forceinline__ void flag_err(unsigned char* ws, int p, float got, float ref, int lane) {
    const float e = fabsf(got - ref) / (fabsf(ref) + 0.5f);
    if (lane == 0) atomicMax((unsigned*)(ws + WS_FLAGS) + p, __float_as_uint(e != e ? 1e9f : e));
}
__device__ __forceinline__ float act_f(float x, int act) { return act == 0 ? x : (act == 1 ? 0.5f * x * (1.f + tanhf(0.7978845608f * (x + 0.044715f * x * x * x))) : x / (1.f + expf(-x))); }
template <int PH> __device__ __forceinline__ void selfcheck(const Args& a) {
    unsigned char* ws = a.ws; const int lane = threadIdx.x & 63, gw = blockIdx.x * 8 + (threadIdx.x >> 6);
    const bf16_t* XN = (const bf16_t*)(ws + WS_XN);
    for (int smp = 0; smp < 4; ++smp) {
        const unsigned hsh = hash32((unsigned)(gw * 4 + smp) * 2654435761u + PH * 977u);
        if (PH == 1) {
            const int col = hsh % N1; int row = (hsh >> 13) % (MX + (SELFCHECK == 1 ? 16 : 0));
            const int seg = col < 1280 ? 0 : (col < 2560 ? 1 : (col < 3584 ? 2 : (col < 4608 ? 3 : (col < 5632 ? 4 : 5))));
            const int act = seg == 1 ? 1 : ((seg == 2 || seg == 5) ? 2 : 0);
            if (act != 0 && row >= MX) row -= 64;
            const float ref = act_f(dot_bf_w(XN + (size_t)row * DM, a.in[3], DM, 8704, col, lane), act);
            const size_t boff = seg == 0 ? WS_AX : (seg == 1 ? WS_AG : (seg == 2 ? WS_Q : (seg == 3 ? WS_F : (seg == 4 ? WS_V : OUT_G))));
            const bf16_t* base = (const bf16_t*)((seg == 5 ? (unsigned char*)a.out : ws) + boff);
            const int ld = seg < 2 ? RGW : DM, c0 = seg == 0 ? 0 : (seg == 1 ? 1280 : (seg == 2 ? 2560 : (seg == 3 ? 3584 : (seg == 4 ? 4608 : 5632))));
            flag_err(ws, 0 + seg, bf2f(base[(size_t)row * ld + col - c0]), ref, lane);
        }
        if (PH == 2) {
            const int col = hsh % 2048, row = (hsh >> 13) % MX;
            const float ref = 1.f / (1.f + expf(-dot_bf_w(XN + (size_t)row * DM, a.in[3], DM, 8704, N1 + col, lane)));
            const bf16_t* base = col < 1024 ? (const bf16_t*)(ws + WS_GA) : (const bf16_t*)(ws + WS_GB);
            const float got = bf2f(base[(size_t)row * DM + (col & 1023)]);
            flag_err(ws, 6, got, ref, lane);
            const bf16_t* wr = (const bf16_t*)(ws + WS_WIN) + (size_t)(N1 + col) * DM; float s2 = 0.f;
            for (int k = lane; k < DM; k += 64) s2 += bf2f(XN[(size_t)row * DM + k]) * bf2f(wr[k]);
            const float ref2 = 1.f / (1.f + expf(-wave_sum(s2)));
            flag_err(ws, 16, ref2, ref, lane);
            flag_err(ws, 17, got, ref2, lane);
            if (lane == 0 && !(fabsf(got - ref) < 0.03f)) { atomicAdd((unsigned*)(ws + WS_FLAGS) + 20, 1u); if (got > 1.01f || got < -0.01f) atomicAdd((unsigned*)(ws + WS_FLAGS) + 21, 1u); }
        }
        if (PH == 3) {
            const int col = hsh % 1024, row = (hsh >> 13) % MX;
            const float pa = dot_bf_w((const bf16_t*)(ws + WS_AG) + (size_t)row * RGW, a.in[13], RGW, DM, col, lane);
            const float pb = dot_bf_w((const bf16_t*)((unsigned char*)a.out + OUT_G) + (size_t)row * DM, a.in[14], DM, DM, col, lane);
            const float ref = bf2f(((const bf16_t*)(ws + WS_GA))[(size_t)row * DM + col]) * pa + bf2f(((const bf16_t*)(ws + WS_GB))[(size_t)row * DM + col]) * pb;
            flag_err(ws, 7, bf2f(((const bf16_t*)(ws + WS_MG))[(size_t)row * DM + col]), ref, lane);
        }
        if (PH == 4) {
            const int col = hsh % 1024, row = (hsh >> 13) % MX;
            const float ref = a.in[0][(size_t)row * DM + col] + dot_bf_w((const bf16_t*)(ws + WS_MG) + (size_t)row * DM, a.in[15], DM, DM, col, lane);
            flag_err(ws, 8, a.out[(size_t)row * DM + col], ref, lane);
        }
        if (PH == 5) {
            const int col = hsh % 1024, row = (hsh >> 13) % MX; float s2 = 0.f;
            for (int k = lane; k < DM; k += 64) { const float v = a.out[(size_t)row * DM + k]; s2 += v * v; }
            const float ref = a.out[(size_t)row * DM + col] * rsqrtf(wave_sum(s2) / 1024.f + EPS) * a.in[16][col];
            flag_err(ws, 9, bf2f(XN[(size_t)row * DM + col]), ref, lane);
        }
        if (PH == 6) {
            const int col = hsh % DFF, row = (hsh >> 13) % MX;
            const float gg = dot_bf_w(XN + (size_t)row * DM, a.in[17], DM, 2 * DFF, col, lane), uu = dot_bf_w(XN + (size_t)row * DM, a.in[17], DM, 2 * DFF, DFF + col, lane);
            flag_err(ws, 10, bf2f(((const bf16_t*)(ws + WS_AG))[(size_t)row * DFF + col]), act_f(gg, 2) * uu, lane);
        }
        if (PH == 7) {
            const int col = hsh % 1024, row = (hsh >> 13) % MX;
            const float ref = a.in[0][(size_t)row * DM + col] + dot_bf_w((const bf16_t*)(ws + WS_AX) + (size_t)row * DM, a.in[15], DM, DM, col, lane)
                            + dot_bf_w((const bf16_t*)(ws + WS_AG) + (size_t)row * DFF, a.in[18], DFF, DM, col, lane);
            flag_err(ws, 11, a.out[(size_t)row * DM + col], ref, lane);
        }
    }
}

#define LDS_WAIT2() asm volatile("s_waitcnt lgkmcnt(0)" ::: "memory")
#define XB_TMO      128
#define XB_XCNT(j)  (256  + 64 * (j))
#define XB_XSUB(j)  (1280 + 64 * (j))
#define XB_XGEN(j)  (2304 + 64 * (j))
#define XB_TOP      3328
#define XB_TOPGEN   3392
#define XCD_BAR_WORDS 3456
#define XB_SPIN_CAP (1u << 18)

__device__ __forceinline__ unsigned xb_ld(unsigned* p)              { return __hip_atomic_load(p, __ATOMIC_RELAXED, __HIP_MEMORY_SCOPE_AGENT); }
__device__ __forceinline__ unsigned xb_add(unsigned* p, unsigned v) { return __hip_atomic_fetch_add(p, v, __ATOMIC_RELAXED, __HIP_MEMORY_SCOPE_AGENT); }
__device__ __forceinline__ unsigned xb_xcc_id() { return (unsigned)__builtin_amdgcn_s_getreg((3 << 11) | 20) & 0xFu; }
#define XB_SPIN(cond, bar) do { unsigned _sp = 0; while (cond) { __builtin_amdgcn_s_sleep(1); \
    if ((++_sp & 255u) == 0u) { if (xb_ld(&(bar)[XB_TMO])) break; if (_sp > XB_SPIN_CAP) { atomicAdd(&(bar)[XB_TMO], 1u); break; } } } } while (0)

struct XcdBarrier {
    unsigned* bar; unsigned x;
    volatile LAS unsigned* st;
};

__device__ __forceinline__ XcdBarrier xcd_barrier_post(unsigned* bar, volatile LAS unsigned* st) {
    XcdBarrier b; b.bar = bar; b.x = xb_xcc_id(); b.st = st;
    if (threadIdx.x == 0) (void)xb_add(&bar[XB_XCNT(b.x)], 1u);
    return b;
}
__device__ __forceinline__ void xcd_barrier_complete(unsigned* bar, unsigned x, unsigned& nloc, unsigned& nx) {
    const unsigned G = gridDim.x * gridDim.y * gridDim.z;
    unsigned sum, cnt, mine, sp = 0u;
    for (;;) {
        sum = 0u; cnt = 0u; mine = 0u;
#pragma unroll
        for (unsigned j = 0; j < 16; ++j) { const unsigned c = xb_ld(&bar[XB_XCNT(j)]); sum += c; cnt += (c > 0u) ? 1u : 0u; mine = (j == x) ? c : mine; }
        if (sum == G) break;
        __builtin_amdgcn_s_sleep(1);
        if ((++sp & 255u) == 0u) { if (xb_ld(&bar[XB_TMO])) break; if (sp > XB_SPIN_CAP) { atomicAdd(&bar[XB_TMO], 1u); break; } }
    }
    nloc = mine > 0u ? mine : 1u; nx = cnt > 0u ? cnt : 1u;
}

__device__ __forceinline__ void xcd_barrier(const XcdBarrier& b) {
    asm volatile("s_waitcnt vmcnt(0)" ::: "memory");
    __syncthreads();
    if (threadIdx.x == 0) {
        unsigned* bar = b.bar;
        __builtin_amdgcn_s_waitcnt(0);
        unsigned nloc = b.st[0], nx = b.st[1];
        if (nloc == 0u) { xcd_barrier_complete(bar, b.x, nloc, nx); b.st[0] = nloc; b.st[1] = nx; }
        const unsigned old = xb_add(&bar[XB_XSUB(b.x)], 1u);
        const unsigned gen = old / nloc;
        if (old + 1u == (gen + 1u) * nloc) {
            __builtin_amdgcn_fence(__ATOMIC_RELEASE, "agent");
            asm volatile("s_waitcnt vmcnt(0)" ::: "memory");
            const unsigned og = xb_add(&bar[XB_TOP], 1u);
            const unsigned tg = og / nx;
            if (og + 1u == (tg + 1u) * nx) xb_add(&bar[XB_TOPGEN], 1u);
            else XB_SPIN(xb_ld(&bar[XB_TOPGEN]) == tg, bar);
            __builtin_amdgcn_fence(__ATOMIC_ACQUIRE, "agent");
            xb_add(&bar[XB_XGEN(b.x)], 1u);
            asm volatile("s_waitcnt vmcnt(0)" ::: "memory");
        } else {
            XB_SPIN(xb_ld(&bar[XB_XGEN(b.x)]) == gen, bar);
            __builtin_amdgcn_fence(__ATOMIC_ACQUIRE, "agent");
            asm volatile("s_waitcnt vmcnt(0)" ::: "memory");
        }
    }
    __syncthreads();
}

#ifndef N_LAUNCH
#define N_LAUNCH 1
#endif
__global__ void __launch_bounds__(512, 2) mega(Args a) {
    extern __shared__ __attribute__((aligned(16))) unsigned char lds_raw[];
    LAS unsigned char* lds = (LAS unsigned char*)lds_raw;
    cg::grid_group grid = cg::this_grid();
    const int lo = a.ph_lo, hi = a.ph_hi;
    volatile LAS unsigned* xst = (volatile LAS unsigned*)(lds + 143360);
    if (threadIdx.x < 2) xst[threadIdx.x] = 0u;
    __syncthreads();
    XcdBarrier xbar = xcd_barrier_post((unsigned*)a.ws, xst);
#define IN(k) (lo <= (k) && (k) < hi)
#define SEAM(k) do { if (IN(k) && IN((k) + 1)) { if ((k) == 0) grid.sync(); else xcd_barrier(xbar); } } while (0)
    unsigned char* ws = a.ws; const int G = gridDim.x, bid = blockIdx.x;
    bf16_t* XN = (bf16_t*)(ws + WS_XN);
    if (IN(0)) p0_prologue(lds, a);
    if (SELFCHECK && bid == 0 && threadIdx.x < 64) ((unsigned*)(ws + WS_FLAGS))[threadIdx.x] = 0u;
    SEAM(0);
    if (IN(1)) { pg8::Gemm g{XN, (const bf16_t*)(ws + WS_WIN), MT, N1, DM}; pg8::StaticOrder S; S.init(MT, N1, G, bid);
      EpiP1 E{ws, (unsigned char*)a.out, 0};
      pg8::gemm_phase<EpiP1, pg8::StaticOrder, true, true>(lds, g, S, E); }
    SEAM(1);
    if (SELFCHECK) { selfcheck<1>(a); __threadfence(); grid.sync(); __threadfence(); }
    if (IN(2)) { if (!RG_NAIVE) rg_pass<1>(lds, a); if (!HG_NAIVE) hg_pass<0>(lds, a); }
    SEAM(2);
    if (IN(3)) { if (!HG_NAIVE) hg_pass_b(a); }
    SEAM(3);
    if (IN(4)) { if (RG_NAIVE) rg_naive(lds, a); else rg_pass<2>(lds, a);
                 if (HG_NAIVE) hg_naive(lds, a); else hg_pass<2>(lds, a); }
    SEAM(4);
    if (IN(5)) { pg8::Gemm g{XN, (const bf16_t*)(ws + WS_WIN) + (size_t)N1 * DM, MX, 2048, DM}; pg8::StaticOrder S; S.init(MX, 2048, G, bid);
      EpiP1 E{ws, (unsigned char*)a.out, 26};
      pg8::gemm_phase<EpiP1, pg8::StaticOrder, true, true>(lds, g, S, E); }
    SEAM(5);
    if (SELFCHECK) { selfcheck<2>(a); __threadfence(); grid.sync(); __threadfence(); }
    if (IN(6)) { pg8::StaticOrder S; S.init(MX, DM, G, bid);
      { pg8::Gemm g{(const bf16_t*)(ws + WS_AG), (const bf16_t*)(ws + WS_WPA), MX, DM, RGW};
        EpiMerge<0> E{(const bf16_t*)(ws + WS_GA), nullptr, (bf16_t*)(ws + WS_T1)};
        pg8::gemm_phase<EpiMerge<0>, pg8::StaticOrder, false, true>(lds, g, S, E); }
      __syncthreads();
      { pg8::Gemm g{(const bf16_t*)((unsigned char*)a.out + OUT_G), (const bf16_t*)(ws + WS_WPB), MX, DM, DM};
        EpiMerge<1> E{(const bf16_t*)(ws + WS_GB), (const bf16_t*)(ws + WS_T1), (bf16_t*)(ws + WS_MG)};
        pg8::gemm_phase<EpiMerge<1>, pg8::StaticOrder, false, true>(lds, g, S, E); } }
    SEAM(6);
    if (SELFCHECK) { selfcheck<3>(a); __threadfence(); grid.sync(); __threadfence(); }
    if (IN(7)) { pg8::Gemm g{(const bf16_t*)(ws + WS_MG), (const bf16_t*)(ws + WS_WOUT), MX, DM, DM}; pg8::StaticOrder S; S.init(MX, DM, G, bid);
      EpiRes E{a.in[0], a.out};
      pg8::gemm_phase<EpiRes, pg8::StaticOrder, false, true>(lds, g, S, E); }
    SEAM(7);
    if (SELFCHECK) { selfcheck<4>(a); __threadfence(); grid.sync(); __threadfence(); }
    if (IN(8)) { for (int m = bid * 8 + __builtin_amdgcn_readfirstlane(threadIdx.x >> 6); m < MX; m += G * 8) norm_row_bf16(a.out + (size_t)m * DM, a.in[16], XN + (size_t)m * DM, (int)__lane_id()); }
    SEAM(8);
    if (SELFCHECK) { selfcheck<5>(a); __threadfence(); grid.sync(); __threadfence(); }
    if (IN(9)) { pg8::Gemm g{XN, (const bf16_t*)(ws + WS_WFI), MX, 2 * DFF, DM}; pg8::StaticOrder S; S.init(MX, 2 * DFF, G, bid);
      EpiFfn E{(bf16_t*)(ws + WS_AG)};
      pg8::gemm_phase<EpiFfn, pg8::StaticOrder, true, true>(lds, g, S, E); }
    SEAM(9);
    if (SELFCHECK) { selfcheck<6>(a); __threadfence(); grid.sync(); __threadfence(); }
    if (IN(10)) { pg8::Gemm g{(const bf16_t*)(ws + WS_AG), (const bf16_t*)(ws + WS_WFD), MX, DM, DFF}; pg8::StaticOrder S; S.init(MX, DM, G, bid);
      EpiRes E{a.out, a.out};
      pg8::gemm_phase<EpiRes, pg8::StaticOrder, false, true>(lds, g, S, E); }
    SEAM(10);
    if (SELFCHECK) { selfcheck<7>(a); __threadfence(); grid.sync(); __threadfence(); }
    if (IN(11)) { for (int m = bid * 8 + __builtin_amdgcn_readfirstlane(threadIdx.x >> 6); m < MX; m += G * 8) {
        const int lane = (int)__lane_id();
        float* row = a.out + (size_t)m * DM; f32x4 v[4]; float s = 0.f;
#pragma unroll
        for (int j = 0; j < 4; ++j) { v[j] = ((const f32x4*)row)[lane + 64 * j]; s += (v[j].x * v[j].x + v[j].y * v[j].y) + (v[j].z * v[j].z + v[j].w * v[j].w); }
        const float rstd = rsqrtf(wave_sum(s) * (1.f / 1024.f) + EPS);
#pragma unroll
        for (int j = 0; j < 4; ++j) { const f32x4 gg = ((const f32x4*)a.in[19])[lane + 64 * j]; ((f32x4*)row)[lane + 64 * j] = v[j] * rstd * gg; }
    } }
    if (SELFCHECK) { __threadfence(); grid.sync(); __threadfence(); if (bid == 0 && threadIdx.x == 0) { const unsigned* fl = (const unsigned*)(ws + WS_FLAGS);
        const int mask = (__uint_as_float(fl[6]) > 0.05f ? 1 : 0) + (__uint_as_float(fl[16]) > 0.05f ? 2 : 0) + (__uint_as_float(fl[17]) > 0.05f ? 4 : 0) + (fl[21] > 0 ? 8 : 0);
        const int kk = 1 + (int)fl[20]; for (int i = 0; i < kk; ++i) a.out[i] = 1000.f * (1 + mask); } }
}

extern "C" void kernel_launch(void* const* d_in, const int* in_sizes, int n_in, void* d_out, int out_size, void* d_ws, size_t ws_size, hipStream_t stream) {
    static int ok = 0;
    if (!ok) { (void)hipFuncSetAttribute((const void*)mega, hipFuncAttributeMaxDynamicSharedMemorySize, LDS_BYTES); ok = 1; }
    Args a{};
    for (int i = 0; i < 20; ++i) a.in[i] = (const float*)d_in[i];
    a.out = (float*)d_out; a.ws = (unsigned char*)d_ws;
    if (N_LAUNCH == 1) {
        (void)hipMemsetAsync(d_ws, 0, 65536, stream);
        a.ph_lo = 0; a.ph_hi = 12;
        void* args[] = {&a};
        hipError_t e = hipLaunchCooperativeKernel((const void*)mega, dim3(256), dim3(512), args, LDS_BYTES, stream);
        if (e != hipSuccess) fprintf(stderr, "cooperative launch failed: %s\n", hipGetErrorString(e));
    } else {
        for (int k = 0; k < 12; ++k) { a.ph_lo = k; a.ph_hi = k + 1; hipLaunchKernelGGL(mega, dim3(256), dim3(512), LDS_BYTES, stream, a); }
    }
}
```

```cpp
#include <hip/hip_runtime.h>
#include <hip/hip_cooperative_groups.h>
#include <cstdio>
#include <cstdint>
namespace cg = cooperative_groups;
namespace pg8 {
#define PG8_LAS __attribute__((address_space(3)))
typedef unsigned short bf16_t;
typedef short bf16x8 __attribute__((ext_vector_type(8)));
typedef float f32x4 __attribute__((ext_vector_type(4)));
typedef unsigned u32x4 __attribute__((ext_vector_type(4)));
constexpr int BM = 256, BK = 64, HALF = 128, HTB = HALF * BK * 2  , STAGE_BYTES = 8 * HTB, NXCD = 8, WGM = 8;

__host__ __device__ __forceinline__ int lds_byte(int r, int c) { const int st = (r >> 4) * 2 + (c >> 5), rr = r & 15, cc = c & 31, ob = rr * 64 + cc * 2; return st * 1024 + (ob ^ (((ob >> 9) & 1) << 5)); }
__host__ __device__ __forceinline__ void stage_rc(int b, int& R, int& C) { const int st = b / 1024, sb = b % 1024, swz = sb ^ (((sb >> 9) & 1) << 5); R = (st >> 1) * 16 + swz / 64; C = (st & 1) * 32 + (swz % 64) / 2; }
__host__ __device__ __forceinline__ int perm32(int rho) { const int n = rho >> 4, i = rho & 15; return 8 * (i >> 2) + 4 * n + (i & 3); }

struct Unit { int pm, pn; };
struct Gemm { const bf16_t* A; const bf16_t* Bt; int M, N, K; };

struct StaticOrder {
    int nM, nN, nwg, G, c;
    __host__ __device__ void init(int M, int N, int G_, int c_) { nM = M / BM; nN = N / BM; nwg = nM * nN; G = G_; c = c_; }
    __host__ __device__ bool next(int i, Unit& u) const {
        const long L = (long)i * G + c; if (L >= nwg) return false;
        int wgid = (int)L; { const int q = nwg / NXCD, r = nwg % NXCD, xcd = wgid % NXCD, off = wgid / NXCD; wgid = (xcd < r ? xcd * (q + 1) : r * (q + 1) + (xcd - r) * q) + off; }
        const int nig = WGM * nN, gid = wgid / nig, fm = gid * WGM, gsz = (nM - fm) < WGM ? (nM - fm) : WGM;
        u.pm = fm + ((wgid % nig) % gsz); u.pn = (wgid % nig) / gsz; return true;
    }
    __device__ __forceinline__ void a_ready(const Unit&) const {}
    __device__ __forceinline__ void done(const Unit&) const {}
};
__device__ __forceinline__ unsigned cvt_pk_bf16(float lo, float hi) { unsigned r; asm volatile("v_cvt_pk_bf16_f32 %0, %1, %2" : "=v"(r) : "v"(lo), "v"(hi)); return r; }
template <class Epi, class Sched, bool ALIGN_EPI = false, bool SP2 = false>
__device__ __forceinline__ void gemm_phase(PG8_LAS unsigned char* lds, const Gemm g, const Sched& S, const Epi& E) {
    int tid_ = threadIdx.x; asm volatile("" : "+v"(tid_));
    const int tid = tid_, wid = __builtin_amdgcn_readfirstlane(tid >> 6), lane = tid & 63, wr = wid >> 2, wc = wid & 3, fr = lane & 15, fq = lane >> 4;
    const int K = g.K, nt = K / BK;
    unsigned voffA[2], voffB[2];
#pragma unroll
    for (int i = 0; i < 2; ++i) { int R, C; stage_rc(tid * 16 + i * 8192, R, C); const int Rb = Epi::PERM ? ((R & ~31) + perm32(R & 31)) : R;
        voffA[i] = (unsigned)(R * K + C) * 2u; voffB[i] = (unsigned)(Rb * K + C) * 2u; }
    const size_t kstep = (size_t)(BK * 2);
    const size_t hstep = (size_t)HALF * K * 2;
    const size_t tstep = 2 * hstep;
    const unsigned ldsw = (unsigned)wid * 1024u;
    const int aoff = lds_byte(wr * 64 + fr, fq * 8), boff = lds_byte(wc * 32 + fr, fq * 8);
#define PG8_SA(b, h) (((b) * 2 + (h)) * HTB)
#define PG8_SB(b, h) ((4 + (b) * 2 + (h)) * HTB)
#define PG8_STAGE(bufoff, gbase, voff) do { _Pragma("unroll") for (int _i = 0; _i < 2; ++_i) \
        __builtin_amdgcn_global_load_lds((const unsigned*)((const char*)(gbase) + (voff)[_i]), (PG8_LAS unsigned*)(lds + (bufoff) + ldsw + _i * 8192), 16, 0, 0); } while (0)
#define PG8_LDA(dst, b, h) do { _Pragma("unroll") for (int m = 0; m < 4; ++m) _Pragma("unroll") for (int k = 0; k < 2; ++k) dst[m][k] = *(const PG8_LAS bf16x8*)(lds + PG8_SA(b, h) + aoff + m * 2048 + k * 1024); } while (0)
#define PG8_LDB(dst, b, h) do { _Pragma("unroll") for (int n = 0; n < 2; ++n) _Pragma("unroll") for (int k = 0; k < 2; ++k) dst[n][k] = *(const PG8_LAS bf16x8*)(lds + PG8_SB(b, h) + boff + n * 2048 + k * 1024); } while (0)
#define PG8_MMA(ai, bj, At, Bt) do { __builtin_amdgcn_s_setprio(1); _Pragma("unroll") for (int m = 0; m < 4; ++m) _Pragma("unroll") for (int n = 0; n < 2; ++n) _Pragma("unroll") for (int k = 0; k < 2; ++k) \
        acc[ai][bj][m][n] = __builtin_amdgcn_mfma_f32_16x16x32_bf16(Bt[n][k], At[m][k], acc[ai][bj][m][n], 0, 0, 0); __builtin_amdgcn_s_setprio(0); } while (0)
#define PG8_WAIT_V(n) asm volatile("s_waitcnt vmcnt(" #n ")" ::: "memory")
#define PG8_WAIT_L(n) asm volatile("s_waitcnt lgkmcnt(" #n ")" ::: "memory")
#define PG8_BAR __builtin_amdgcn_s_barrier()
#define PG8_SCHED __builtin_amdgcn_sched_barrier(0)
    Unit cur, nxt; int ui = 0;
    if (!S.next(0, cur)) return;
    f32x4 acc[2][2][4][2];
#pragma unroll
    for (int a = 0; a < 2; ++a)
#pragma unroll
        for (int b = 0; b < 2; ++b)
#pragma unroll
            for (int m = 0; m < 4; ++m)
#pragma unroll
                for (int n = 0; n < 2; ++n) acc[a][b][m][n] = (f32x4){0.f, 0.f, 0.f, 0.f};
    bf16x8 At[4][2], B0[2][2], B1[2][2];
    const char* cA = (const char*)g.A + (size_t)cur.pm * tstep; const char* cB = (const char*)g.Bt + (size_t)cur.pn * tstep;
    S.a_ready(cur);
    if constexpr (SP2) {
        PG8_STAGE(PG8_SB(0, 0), cB, voffB); PG8_STAGE(PG8_SB(0, 1), cB + hstep, voffB); PG8_STAGE(PG8_SA(0, 0), cA, voffA); PG8_STAGE(PG8_SA(0, 1), cA + hstep, voffA);
        if (wr == 1) PG8_BAR;
        PG8_WAIT_V(2); PG8_BAR;
        PG8_STAGE(PG8_SB(1, 0), cB + kstep, voffB); PG8_STAGE(PG8_SA(1, 0), cA + kstep, voffA); PG8_STAGE(PG8_SB(1, 1), cB + hstep + kstep, voffB);
        PG8_WAIT_V(6); PG8_BAR;
    } else {
        PG8_STAGE(PG8_SB(0, 0), cB, voffB); PG8_STAGE(PG8_SA(0, 0), cA, voffA); PG8_STAGE(PG8_SB(0, 1), cB + hstep, voffB); PG8_STAGE(PG8_SA(0, 1), cA + hstep, voffA);
        if (wr == 1) PG8_BAR;
        PG8_WAIT_V(4); PG8_BAR;
        PG8_STAGE(PG8_SB(1, 0), cB + kstep, voffB); PG8_STAGE(PG8_SA(1, 0), cA + kstep, voffA); PG8_STAGE(PG8_SB(1, 1), cB + hstep + kstep, voffB);
        PG8_WAIT_V(6); PG8_BAR;
    }
    for (;;) {
        const bool has_next = S.next(ui + 1, nxt);
        const char* nA = has_next ? (const char*)g.A + (size_t)nxt.pm * tstep : cA; const char* nB = has_next ? (const char*)g.Bt + (size_t)nxt.pn * tstep : cB;
        for (int t = 0; t < nt; t += 2) {
            const bool last = (t == nt - 2);
            const char* a1 = cA + (size_t)(t + 1) * kstep;
            const char* a2 = last ? nA : cA + (size_t)(t + 2) * kstep; const char* b2 = last ? nB : cB + (size_t)(t + 2) * kstep;
            const char* a3 = a2 + kstep; const char* b3 = b2 + kstep;
            if (last && has_next) S.a_ready(nxt);
            if constexpr (SP2) {
            PG8_LDB(B0, 0, 0); PG8_LDB(B1, 0, 1); PG8_SCHED; PG8_LDA(At, 0, 0); PG8_STAGE(PG8_SA(1, 1), a1 + hstep, voffA);
            PG8_WAIT_V(8); PG8_WAIT_L(0); PG8_BAR; PG8_MMA(0, 0, At, B0); PG8_MMA(0, 1, At, B1); PG8_BAR; PG8_SCHED;
            PG8_LDA(At, 0, 1); PG8_STAGE(PG8_SB(0, 0), b2, voffB); PG8_STAGE(PG8_SB(0, 1), b2 + hstep, voffB); PG8_STAGE(PG8_SA(0, 0), a2, voffA);
            PG8_WAIT_V(8); PG8_WAIT_L(0); PG8_BAR; PG8_MMA(1, 0, At, B0); PG8_MMA(1, 1, At, B1); PG8_BAR; PG8_SCHED;
            PG8_LDB(B0, 1, 0); PG8_LDB(B1, 1, 1); PG8_SCHED; PG8_LDA(At, 1, 0); PG8_STAGE(PG8_SA(0, 1), a2 + hstep, voffA);
            PG8_WAIT_V(8); PG8_WAIT_L(0); PG8_BAR; PG8_MMA(0, 0, At, B0); PG8_MMA(0, 1, At, B1); PG8_BAR; PG8_SCHED;
            PG8_LDA(At, 1, 1); PG8_STAGE(PG8_SB(1, 0), b3, voffB); PG8_STAGE(PG8_SB(1, 1), b3 + hstep, voffB); PG8_STAGE(PG8_SA(1, 0), a3, voffA);
            PG8_WAIT_V(8); PG8_WAIT_L(0); PG8_BAR; PG8_MMA(1, 0, At, B0); PG8_MMA(1, 1, At, B1); PG8_BAR; PG8_SCHED;
            } else {
            PG8_LDB(B0, 0, 0); PG8_SCHED; PG8_LDA(At, 0, 0); PG8_STAGE(PG8_SA(1, 1), a1 + hstep, voffA);
            PG8_WAIT_L(8); PG8_BAR; PG8_WAIT_L(0); PG8_MMA(0, 0, At, B0); PG8_BAR; PG8_SCHED;
            PG8_LDB(B1, 0, 1); PG8_STAGE(PG8_SB(0, 0), b2, voffB);
            PG8_BAR; PG8_WAIT_L(0); PG8_MMA(0, 1, At, B1); PG8_BAR;
            PG8_LDA(At, 0, 1); PG8_STAGE(PG8_SA(0, 0), a2, voffA);
            PG8_BAR; PG8_WAIT_L(0); PG8_MMA(1, 0, At, B0); PG8_BAR; PG8_SCHED;
            PG8_STAGE(PG8_SB(0, 1), b2 + hstep, voffB);
            PG8_WAIT_V(6); PG8_BAR; PG8_MMA(1, 1, At, B1); PG8_BAR;
            PG8_LDB(B0, 1, 0); PG8_SCHED; PG8_LDA(At, 1, 0); PG8_STAGE(PG8_SA(0, 1), a2 + hstep, voffA);
            PG8_WAIT_L(8); PG8_BAR; PG8_WAIT_L(0); PG8_MMA(0, 0, At, B0); PG8_BAR; PG8_SCHED;
            PG8_LDB(B1, 1, 1); PG8_STAGE(PG8_SB(1, 0), b3, voffB);
            PG8_BAR; PG8_WAIT_L(0); PG8_MMA(0, 1, At, B1); PG8_BAR;
            PG8_LDA(At, 1, 1); PG8_STAGE(PG8_SA(1, 0), a3, voffA);
            PG8_BAR; PG8_WAIT_L(0); PG8_MMA(1, 0, At, B0); PG8_BAR; PG8_SCHED;
            PG8_STAGE(PG8_SB(1, 1), b3 + hstep, voffB);
            PG8_WAIT_V(6); PG8_BAR; PG8_MMA(1, 1, At, B1); PG8_BAR;
            }
        }
        if constexpr (ALIGN_EPI) { if (wr == 0) PG8_BAR; }
        if constexpr (!Epi::AFTER_DRAIN) { E(acc, cur, wr, wc, fr, fq); S.done(cur); }
        if (!has_next) break;
#pragma unroll
        for (int a = 0; a < 2; ++a)
#pragma unroll
            for (int b = 0; b < 2; ++b)
#pragma unroll
                for (int m = 0; m < 4; ++m)
#pragma unroll
                    for (int n = 0; n < 2; ++n) acc[a][b][m][n] = (f32x4){0.f, 0.f, 0.f, 0.f};
        cur = nxt; cA = nA; cB = nB; ++ui;
        if constexpr (ALIGN_EPI) { if (wr == 1) PG8_BAR; }
    }
    PG8_WAIT_V(0);
    if constexpr (!ALIGN_EPI) { if (wr == 0) PG8_BAR; }
    PG8_BAR;
    if constexpr (Epi::AFTER_DRAIN) { E.fused(acc, cur, wr, wc, fr, fq, lds, wid, lane); S.done(cur); }
#undef PG8_SA
#undef PG8_SB
#undef PG8_STAGE
#undef PG8_LDA
#undef PG8_LDB
#undef PG8_MMA
#undef PG8_WAIT_V
#undef PG8_WAIT_L
#undef PG8_BAR
#undef PG8_SCHED
}
}
using pg8::bf16_t; using pg8::bf16x8; using pg8::f32x4; using pg8::u32x4; using pg8::Unit; using pg8::cvt_pk_bf16;
#define LAS __attribute__((address_space(3)))
typedef unsigned u32x2 __attribute__((ext_vector_type(2)));

constexpr int MX = 16384, MT = 16640, DM = 1024, RGW = 1280, DFF = 2816, N1 = 6656;
constexpr float EPS = 1e-6f;
constexpr size_t MiB = (size_t)1 << 20;
constexpr size_t WS_WIN = 1 * MiB;
constexpr size_t WS_WPA = 18 * MiB;
constexpr size_t WS_WPB = WS_WPA + 2621440;
constexpr size_t WS_WOUT = WS_WPB + 2 * MiB;
constexpr size_t WS_WFI = WS_WOUT + 2 * MiB;
constexpr size_t WS_WFD = WS_WFI + 11 * MiB;
constexpr size_t WS_MISC = 41 * MiB;
constexpr size_t WS_GFRAG = WS_MISC;
constexpr size_t WS_RGAGG = WS_MISC + 512 * 1024;
constexpr size_t WS_RGAGM = WS_MISC + 1792 * 1024;
constexpr size_t WS_HGD = WS_MISC + 1856 * 1024;
constexpr size_t WS_HGSM = WS_MISC + 2112 * 1024;
constexpr size_t WS_XN = 44 * MiB;
constexpr size_t WS_AX = WS_XN + (size_t)MT * DM * 2;
constexpr size_t WS_AG = WS_AX + (size_t)MT * RGW * 2;
constexpr size_t WS_Q = WS_AG + (size_t)MX * RGW * 2;
constexpr size_t WS_F = WS_Q + (size_t)MX * DM * 2;
constexpr size_t WS_V = WS_F + (size_t)MT * DM * 2;
static_assert(WS_V + (size_t)MT * DM * 2 <= 256 * MiB, "ws map");
static_assert(WS_AG + (size_t)MX * DFF * 2 <= WS_V, "ACT overlay");
constexpr size_t WS_GA = WS_AX, WS_GB = WS_V, WS_T1 = WS_Q, WS_MG = WS_F;
constexpr size_t OUT_G = 0, OUT_HGS = 32 * MiB;
constexpr int LDS_BYTES = 147456;

struct Args { const float* in[20]; float* out; unsigned char* ws; int ph_lo, ph_hi; };

__device__ __forceinline__ float bf2f(unsigned short b) { return __uint_as_float(((unsigned)b) << 16); }
__device__ __forceinline__ float bflo(unsigned w) { return __uint_as_float(w << 16); }
__device__ __forceinline__ float bfhi(unsigned w) { return __uint_as_float(w & 0xffff0000u); }
__device__ __forceinline__ unsigned short f2bf(float f) { unsigned u = __float_as_uint(f); return (unsigned short)((u + 0x7fffu + ((u >> 16) & 1u)) >> 16); }
__device__ __forceinline__ float sigm(float x) { return __builtin_amdgcn_rcpf(1.f + __expf(-x)); }
__device__ __forceinline__ float wave_sum(float v) {
#pragma unroll
    for (int o = 1; o < 64; o <<= 1) v += __shfl_xor(v, o);
    return v;
}
#define LDS_WAIT() asm volatile("s_waitcnt lgkmcnt(0)" ::: "memory")
__device__ __forceinline__ int tok_row(int b, int s) { return s >= 0 ? b * 8192 + s : (s >= -16 ? 16400 + s : -1); }

__device__ __forceinline__ void transpose_item(const float* W, int K, int N, bf16_t* WT, int dst_row0, int k0, int n0, LAS float* scr, int lane) {
#pragma unroll 8
    for (int i = 0; i < 32; ++i) { const int kk = 2 * i + (lane >> 5); scr[kk * 33 + (lane & 31)] = W[(size_t)(k0 + kk) * N + n0 + (lane & 31)]; }
    LDS_WAIT();
    const int c = lane & 7;
#pragma unroll
    for (int j = 0; j < 4; ++j) { const int n = (lane >> 3) + 8 * j; const LAS float* s = scr + (8 * c) * 33 + n;
        u32x4 o; o.x = cvt_pk_bf16(s[0 * 33], s[1 * 33]); o.y = cvt_pk_bf16(s[2 * 33], s[3 * 33]); o.z = cvt_pk_bf16(s[4 * 33], s[5 * 33]); o.w = cvt_pk_bf16(s[6 * 33], s[7 * 33]);
        *(u32x4*)(WT + (size_t)(dst_row0 + n) * K + k0 + 8 * c) = o; }
    LDS_WAIT();
}
__device__ __forceinline__ void norm_row_bf16(const float* xrow, const float* g, bf16_t* orow, int lane) {
    f32x4 v[4]; float s = 0.f;
#pragma unroll
    for (int j = 0; j < 4; ++j) { v[j] = xrow ? ((const f32x4*)xrow)[lane + 64 * j] : (f32x4){0.f, 0.f, 0.f, 0.f}; s += (v[j].x * v[j].x + v[j].y * v[j].y) + (v[j].z * v[j].z + v[j].w * v[j].w); }
    const float rstd = rsqrtf(wave_sum(s) * (1.f / 1024.f) + EPS);
#pragma unroll
    for (int j = 0; j < 4; ++j) { const f32x4 gg = ((const f32x4*)g)[lane + 64 * j]; u32x2 o; o.x = cvt_pk_bf16(v[j].x * rstd * gg.x, v[j].y * rstd * gg.y); o.y = cvt_pk_bf16(v[j].z * rstd * gg.z, v[j].w * rstd * gg.w);
        ((u32x2*)orow)[lane + 64 * j] = o; }
}
__device__ __forceinline__ void p0_prologue(LAS unsigned char* lds, const Args& a) {
    const int tid = threadIdx.x, lane = tid & 63, wid = tid >> 6;
    LAS float* scr = (LAS float*)(lds + wid * 16384);
    const int gw = blockIdx.x * 8 + wid, NGW = gridDim.x * 8;
    unsigned char* ws = a.ws;
    for (int it = gw; it < 4352; it += NGW) { const int kb = it / 272, nb = it % 272; transpose_item(a.in[3], 1024, 8704, (bf16_t*)(ws + WS_WIN), 32 * nb, 64 * kb, 32 * nb, scr, lane); }
    for (int m = gw; m < MT; m += NGW) {
        const float* src = m < MX ? a.in[0] + (size_t)m * DM : (m < MX + 16 ? a.in[1] + (size_t)(m - MX) * DM : nullptr);
        norm_row_bf16(src, a.in[2], (bf16_t*)(ws + WS_XN) + (size_t)m * DM, lane);
    }
    for (int idx = blockIdx.x * 512 + tid; idx < 30720; idx += gridDim.x * 512) {
        const int l = idx & 63, f = idx >> 6, ks = f % 3, nt = (f / 3) % 5, n = (f / 15) % 16, g = f / 240, quad = l >> 4, col = l & 15;
        const float* W = (g ? a.in[8] : a.in[6]) + (size_t)n * 6400;
        float v[8];
#pragma unroll
        for (int j = 0; j < 8; ++j) { const int k = 32 * ks + 8 * quad + j; v[j] = k < 80 ? W[k * 80 + 16 * nt + col] : 0.f; }
        u32x4 o; o.x = cvt_pk_bf16(v[0], v[1]); o.y = cvt_pk_bf16(v[2], v[3]); o.z = cvt_pk_bf16(v[4], v[5]); o.w = cvt_pk_bf16(v[6], v[7]);
        ((u32x4*)(ws + WS_GFRAG))[idx] = o;
    }
}

__device__ __forceinline__ void p0_late_weights(LAS unsigned char* lds, const Args& a, int gw, int NGW) {
    int tid_ = threadIdx.x; asm volatile("" : "+v"(tid_));
    const int lane = tid_ & 63, wid = tid_ >> 6;
    LAS float* scr = (LAS float*)(lds + wid * 16384);
    unsigned char* ws = a.ws;
    for (int it = gw; it < 5888; it += NGW) {
        int r = it;
        if (r < 640) { const int kb = r / 32, nb = r % 32; transpose_item(a.in[13], 1280, 1024, (bf16_t*)(ws + WS_WPA), 32 * nb, 64 * kb, 32 * nb, scr, lane); continue; } r -= 640;
        if (r < 512) { const int kb = r / 32, nb = r % 32; transpose_item(a.in[14], 1024, 1024, (bf16_t*)(ws + WS_WPB), 32 * nb, 64 * kb, 32 * nb, scr, lane); continue; } r -= 512;
        if (r < 512) { const int kb = r / 32, nb = r % 32; transpose_item(a.in[15], 1024, 1024, (bf16_t*)(ws + WS_WOUT), 32 * nb, 64 * kb, 32 * nb, scr, lane); continue; } r -= 512;
        if (r < 2816) { const int kb = r / 176, nb = r % 176; const int n0 = 32 * nb; const int nn = n0 < 2816 ? n0 : n0 - 2816;
            const int dr = (nn >> 7) * 256 + (n0 < 2816 ? 0 : 128) + (nn & 127);
            transpose_item(a.in[17], 1024, 5632, (bf16_t*)(ws + WS_WFI), dr, 64 * kb, n0, scr, lane); continue; } r -= 2816;
        { const int kb = r / 32, nb = r % 32; transpose_item(a.in[18], 2816, 1024, (bf16_t*)(ws + WS_WFD), 32 * nb, 64 * kb, 32 * nb, scr, lane); }
    }
}

template <int PASS, bool DRY = false>
__device__ __forceinline__ void rg_pass(LAS unsigned char* lds, const Args& a) {
    int tid_ = threadIdx.x; asm volatile("" : "+v"(tid_));
    const int tid = tid_, lane = tid & 63, wid = tid >> 6, quad = lane >> 4, col = lane & 15;
    const int g = blockIdx.x, n = g & 15, sc = (g >> 4) & 7, b = g >> 7;
    unsigned char* ws = a.ws;
    LAS u32x4* bfr = (LAS u32x4*)lds; LAS float* cw = (LAS float*)(lds + 30720); LAS float* cb = (LAS float*)(lds + 32256);
    { const u32x4* gf = (const u32x4*)(ws + WS_GFRAG);
      for (int i = tid; i < 1920; i += 512) { const int f = i >> 6, l = i & 63, gs = f / 15, r = f % 15; bfr[i] = gf[((gs * 16 + n) * 15 + r) * 64 + l]; }
      for (int i = tid; i < 384; i += 512) { const int j = i / 96, c = i % 96; cw[i] = c < 80 ? a.in[4][j * 1280 + 80 * n + c] : 0.f; }
      if (tid < 96) cb[tid] = tid < 80 ? a.in[5][80 * n + tid] : 0.f; }
    __syncthreads();
    float ba[5], bx[5], sp[5], h[5], ap[5];
#pragma unroll
    for (int nt = 0; nt < 5; ++nt) { const int c = 80 * n + 16 * nt + col; ba[nt] = a.in[7][c]; bx[nt] = a.in[9][c]; sp[nt] = 8.f * log1pf(__expf(-a.in[10][c])); h[nt] = 0.f; ap[nt] = 1.f; }
    const int c = 8 * sc + wid;
    float* agg = (float*)(ws + WS_RGAGG); float* aggm = (float*)(ws + WS_RGAGM);
    if (PASS == 2) {
        LAS float* AGL = (LAS float*)(lds + 32768); LAS float* CAR = (LAS float*)(lds + 73728);
        const f32x4* ag4 = (const f32x4*)(agg + (size_t)((b * 16 + n) * 64) * 160);
        for (int i = tid; i < 2560; i += 512) ((LAS f32x4*)AGL)[i] = ag4[i];
        __syncthreads();
        if (tid < 80) { float hc = aggm[(n * 2 + 1) * 80 + tid];
            for (int j = 0; j < 64; ++j) { CAR[j * 80 + tid] = hc; hc = AGL[j * 160 + tid] * hc + AGL[j * 160 + 80 + tid]; } }
        __syncthreads();
#pragma unroll
        for (int nt = 0; nt < 5; ++nt) h[nt] = CAR[c * 80 + 16 * nt + col];
    }
    bf16x8 idE, idO;
#pragma unroll
    for (int j = 0; j < 8; ++j) { idE[j] = (8 * quad + j == col) ? (short)0x3F80 : (short)0; idO[j] = (8 * quad + j == 16 + col) ? (short)0x3F80 : (short)0; }
    const bf16_t* AX = (const bf16_t*)(ws + WS_AX); bf16_t* AG = (bf16_t*)(ws + WS_AG);
    const int ntile = 8 + ((PASS == 1 && b == 0 && sc == 0 && wid == 0) ? 1 : 0);
    for (int it = 0; it < ntile; ++it) {
        if (PASS == 1 && it == 8) {
            if (quad == 0) {
#pragma unroll
                for (int nt = 0; nt < 5; ++nt) { agg[(size_t)((b * 16 + n) * 64 + c) * 160 + 16 * nt + col] = ap[nt]; agg[(size_t)((b * 16 + n) * 64 + c) * 160 + 80 + 16 * nt + col] = h[nt]; } }
#pragma unroll
            for (int nt = 0; nt < 5; ++nt) { h[nt] = 0.f; ap[nt] = 1.f; }
        }
        const int s0 = it < 8 ? 128 * c + 16 * it : -16;
        unsigned short gv[20];
        if (PASS == 2) {
#pragma unroll
            for (int nt = 0; nt < 5; ++nt)
#pragma unroll
                for (int r = 0; r < 4; ++r) gv[nt * 4 + r] = AG[(size_t)(b * 8192 + s0 + 4 * quad + r) * RGW + 80 * n + 16 * nt + col];
        }
        bf16x8 af[3];
        const int s = s0 + col;
#pragma unroll
        for (int ks = 0; ks < 3; ++ks) {
            const int ch = 32 * ks + 8 * quad;
            if (ch < 80) {
                const f32x4 b0 = *(const LAS f32x4*)(cb + ch), b1 = *(const LAS f32x4*)(cb + ch + 4);
                float xc[8] = {b0.x, b0.y, b0.z, b0.w, b1.x, b1.y, b1.z, b1.w};
                u32x4 wv[4];
#pragma unroll
                for (int j = 0; j < 4; ++j) { const int r = tok_row(b, s - 3 + j); wv[j] = *(const u32x4*)(AX + (size_t)(r < 0 ? 16384 : r) * RGW + 80 * n + ch); if (r < 0) wv[j] = (u32x4){0u, 0u, 0u, 0u}; }
#pragma unroll
                for (int j = 0; j < 4; ++j) {
                    const u32x4 w = wv[j];
                    const f32x4 w0 = *(const LAS f32x4*)(cw + j * 96 + ch), w1 = *(const LAS f32x4*)(cw + j * 96 + ch + 4);
                    xc[0] += w0.x * bflo(w.x); xc[1] += w0.y * bfhi(w.x); xc[2] += w0.z * bflo(w.y); xc[3] += w0.w * bfhi(w.y);
                    xc[4] += w1.x * bflo(w.z); xc[5] += w1.y * bfhi(w.z); xc[6] += w1.z * bflo(w.w); xc[7] += w1.w * bfhi(w.w);
                }
                u32x4 p; p.x = cvt_pk_bf16(xc[0], xc[1]); p.y = cvt_pk_bf16(xc[2], xc[3]); p.z = cvt_pk_bf16(xc[4], xc[5]); p.w = cvt_pk_bf16(xc[6], xc[7]);
                af[ks] = __builtin_bit_cast(bf16x8, p);
            } else af[ks] = (bf16x8){0, 0, 0, 0, 0, 0, 0, 0};
        }
#pragma unroll
        for (int nt = 0; nt < 5; ++nt) {
            f32x4 aR = {0.f, 0.f, 0.f, 0.f}, aI = {0.f, 0.f, 0.f, 0.f}, aX = {0.f, 0.f, 0.f, 0.f};
#pragma unroll
            for (int ks = 0; ks < 3; ++ks) {
                const bf16x8 bR = __builtin_bit_cast(bf16x8, bfr[(nt * 3 + ks) * 64 + lane]), bI = __builtin_bit_cast(bf16x8, bfr[((5 + nt) * 3 + ks) * 64 + lane]);
                aR = __builtin_amdgcn_mfma_f32_16x16x32_bf16(af[ks], bR, aR, 0, 0, 0);
                aI = __builtin_amdgcn_mfma_f32_16x16x32_bf16(af[ks], bI, aI, 0, 0, 0);
            }
            aX = __builtin_amdgcn_mfma_f32_16x16x32_bf16(af[nt >> 1], (nt & 1) ? idO : idE, aX, 0, 0, 0);
            float pa[4], ha[4];
#pragma unroll
            for (int r = 0; r < 4; ++r) {
                const float rr = sigm(aR[r] + ba[nt]), ii = sigm(aI[r] + bx[nt]);
                const float la = -rr * sp[nt], av = __expf(la), x2 = 2.f * la;
                const float om = x2 > -0.02f ? -x2 * (1.f + 0.5f * x2 * (1.f + x2 * (1.f / 3.f))) : 1.f - av * av;
                const float uu = sqrtf(om) * ii * aX[r];
                if (r == 0) { pa[0] = av; ha[0] = uu; } else { pa[r] = pa[r - 1] * av; ha[r] = av * ha[r - 1] + uu; }
            }
            float PA = 1.f, HA = 0.f;
#pragma unroll
            for (int j = 0; j < 3; ++j) { const float pj = __shfl(pa[3], col + 16 * j), hj = __shfl(ha[3], col + 16 * j); if (j < quad) { HA = pj * HA + hj; PA = pj * PA; } }
            const float hq = PA * h[nt] + HA;
            float o[4];
#pragma unroll
            for (int r = 0; r < 4; ++r) o[r] = pa[r] * hq + ha[r];
            h[nt] = __shfl(o[3], 48 + col);
            ap[nt] *= __shfl(pa[3] * PA, 48 + col);
            if (PASS == 2) {
#pragma unroll
                for (int r = 0; r < 4; ++r) { const bf16_t yv = f2bf(o[r] * bf2f(gv[nt * 4 + r])); if (!DRY || yv == 0x7fff) AG[(size_t)(b * 8192 + s0 + 4 * quad + r) * RGW + 80 * n + 16 * nt + col] = yv; }
            }
        }
    }
    if (PASS == 1 && quad == 0) {
        float* dst = ntile == 9 ? aggm + (size_t)n * 160 : agg + (size_t)((b * 16 + n) * 64 + c) * 160;
#pragma unroll
        for (int nt = 0; nt < 5; ++nt) { dst[16 * nt + col] = ap[nt]; dst[80 + 16 * nt + col] = h[nt]; }
    }
    __syncthreads();
}

constexpr int HQE = 0, HKE = 17408, HKDT = 34816, HVT = 53248, HPB = 71680, HOB = 80896, HPART = 114688, HEM = 116736, HEB = 117248;
template <int PASS, bool DRY = false>
__device__ __forceinline__ void hg_pass(LAS unsigned char* lds, const Args& a) {
    int tid_ = threadIdx.x; asm volatile("" : "+v"(tid_));
    const int tid = tid_, lane = tid & 63, wid = tid >> 6, quad = lane >> 4, col = lane & 15;
    const int k = tid & 127, tq = tid >> 7;
    unsigned char* ws = a.ws;
    const bf16_t* Fb = (const bf16_t*)(ws + WS_F); const bf16_t* Vb = (const bf16_t*)(ws + WS_V); const bf16_t* Qb = (const bf16_t*)(ws + WS_Q);
    bf16_t* Gb = (bf16_t*)((unsigned char*)a.out + OUT_G);
    float* ST = (float*)((unsigned char*)a.out + OUT_HGS); float* STM = (float*)(ws + WS_HGSM); float* HD = (float*)(ws + WS_HGD);
    LAS float* PART = (LAS float*)(lds + HPART); LAS float* EM = (LAS float*)(lds + HEM); LAS float* EB = (LAS float*)(lds + HEB); LAS float* OB = (LAS float*)(lds + HOB);
    const int nunits = PASS == 0 ? 520 : 512;
    for (int u = blockIdx.x; u < nunits; u += gridDim.x) {
        const bool meta = u >= 512;
        const int hh = meta ? u - 512 : (u >> 5) & 7, b = meta ? 0 : u >> 8, j = u & 31, nchunk = meta ? 1 : 4;
        const float lbv = __builtin_amdgcn_rcpf(1.f + __expf(a.in[11][1024 + hh * 128 + k] - a.in[11][hh * 128 + k]));
        f32x4 S[8];
        if (PASS == 0) {
#pragma unroll
            for (int kb = 0; kb < 8; ++kb) S[kb] = (f32x4){0.f, 0.f, 0.f, 0.f};
        } else {
            const float* sp = ST + (size_t)u * 16384 + 16 * wid + col;
#pragma unroll
            for (int kb = 0; kb < 8; ++kb)
#pragma unroll
                for (int r = 0; r < 4; ++r) S[kb][r] = sp[(16 * kb + 4 * quad + r) * 128];
        }
        float btot = 0.f;
        unsigned short fr16[16];
        {   const int s0 = meta ? -64 : 256 * j;
#pragma unroll
            for (int i = 0; i < 16; ++i) {
                const int r = tok_row(b, s0 + 16 * tq + i), rc = r < 0 ? 16384 : r;
                fr16[i] = Fb[(size_t)rc * DM + hh * 128 + k];
            } }
        for (int ci = 0; ci < nchunk; ++ci) {
            const int s0 = meta ? -64 : 256 * j + 64 * ci;
            u32x4 gpre0, gpre1;
            if (PASS == 2) { const u32x4* gpp = (const u32x4*)(Gb + (size_t)(b * 8192 + s0 + (tid >> 3)) * DM + hh * 128 + (tid & 7) * 16); gpre0 = gpp[0]; gpre1 = gpp[1]; }
            unsigned short qr16[16], vr[16];
#pragma unroll
            for (int i = 0; i < 16; ++i) {
                const int r = tok_row(b, s0 + 16 * tq + i), rc = r < 0 ? 16384 : r;
                vr[i] = Vb[(size_t)rc * DM + hh * 128 + k];
                if (PASS == 2) qr16[i] = Qb[(size_t)rc * DM + hh * 128 + k];
            }
            unsigned short fn[16];
            if (ci + 1 < nchunk) {
#pragma unroll
                for (int i = 0; i < 16; ++i) fn[i] = Fb[(size_t)(b * 8192 + s0 + 64 + 16 * tq + i) * DM + hh * 128 + k];
            }
            float bc[16], kv[16];
            float csum = 0.f;
#pragma unroll
            for (int i = 0; i < 16; ++i) {
                const bool valid = !meta || tq == 3;
                float fl = bf2f(fr16[i]); fl = fminf(fmaxf(fl, -30.f), 30.f);
                const float e = __expf(-fl), sg = __builtin_amdgcn_rcpf(1.f + e);
                csum += valid ? __logf(lbv + (1.f - lbv) * sg) : 0.f; kv[i] = valid ? (1.f - lbv) * e * sg : 0.f;
                if (!valid) vr[i] = 0;
                bc[i] = csum;
            }
            PART[tq * 128 + k] = csum;
            __syncthreads();
            const float p0 = PART[k], p1 = PART[128 + k], p2 = PART[256 + k], p3 = PART[384 + k];
            const float off = tq == 0 ? 0.f : (tq == 1 ? p0 : (tq == 2 ? p0 + p1 : p0 + p1 + p2));
            const float blast = (p0 + p1) + (p2 + p3), mid = p0 + p1;
            btot += blast;
            {
                unsigned kw[8], vw[8];
#pragma unroll
                for (int i = 0; i < 8; ++i) {
                    const float e0 = __expf(blast - (off + bc[2 * i])), e1 = __expf(blast - (off + bc[2 * i + 1]));
                    kw[i] = cvt_pk_bf16(kv[2 * i] * e0, kv[2 * i + 1] * e1); vw[i] = (unsigned)vr[2 * i] | ((unsigned)vr[2 * i + 1] << 16);
                }
                LAS u32x4* kd = (LAS u32x4*)(lds + HKDT + k * 144 + tq * 32); kd[0] = (u32x4){kw[0], kw[1], kw[2], kw[3]}; kd[1] = (u32x4){kw[4], kw[5], kw[6], kw[7]};
                LAS u32x4* vt = (LAS u32x4*)(lds + HVT + k * 144 + tq * 32); vt[0] = (u32x4){vw[0], vw[1], vw[2], vw[3]}; vt[1] = (u32x4){vw[4], vw[5], vw[6], vw[7]};
            }
            if (PASS == 2) {
#pragma unroll
                for (int i = 0; i < 16; ++i) {
                    const float d = off + bc[i] - mid; const int t = 16 * tq + i;
                    *(LAS bf16_t*)(lds + HQE + t * 272 + k * 2) = f2bf(bf2f(qr16[i]) * __expf(fminf(d, 80.f)));
                    *(LAS bf16_t*)(lds + HKE + t * 272 + k * 2) = f2bf(kv[i] * __expf(fminf(-d, 80.f)));
                }
            }
            if (tq == 0) { EB[k] = __expf(blast); EM[k] = __expf(mid); }
            __syncthreads();
            bf16x8 vf[2];
#pragma unroll
            for (int ks = 0; ks < 2; ++ks) vf[ks] = *(const LAS bf16x8*)(lds + HVT + (16 * wid + col) * 144 + ks * 64 + quad * 16);
            if (PASS == 2) {
                {
                    const int I = wid >> 1, sh = wid & 1;
                    f32x4 p0a = {0.f, 0.f, 0.f, 0.f}, p1a = {0.f, 0.f, 0.f, 0.f};
#pragma unroll
                    for (int ks = 0; ks < 4; ++ks) {
                        const bf16x8 qa = *(const LAS bf16x8*)(lds + HQE + (16 * I + col) * 272 + ks * 64 + quad * 16);
                        const bf16x8 k0 = *(const LAS bf16x8*)(lds + HKE + (32 * sh + col) * 272 + ks * 64 + quad * 16);
                        const bf16x8 k1 = *(const LAS bf16x8*)(lds + HKE + (32 * sh + 16 + col) * 272 + ks * 64 + quad * 16);
                        p0a = __builtin_amdgcn_mfma_f32_16x16x32_bf16(qa, k0, p0a, 0, 0, 0);
                        p1a = __builtin_amdgcn_mfma_f32_16x16x32_bf16(qa, k1, p1a, 0, 0, 0);
                    }
#pragma unroll
                    for (int r = 0; r < 4; ++r) { const int t = 16 * I + 4 * quad + r, sa = 32 * sh + col;
                        *(LAS bf16_t*)(lds + HPB + t * 144 + sa * 2) = sa <= t ? f2bf(p0a[r]) : (bf16_t)0;
                        *(LAS bf16_t*)(lds + HPB + t * 144 + (sa + 16) * 2) = sa + 16 <= t ? f2bf(p1a[r]) : (bf16_t)0; }
                }
                bf16x8 sf[4];
#pragma unroll
                for (int ks = 0; ks < 4; ++ks) {
                    const f32x4 ea = *(const LAS f32x4*)(EM + 32 * ks + 4 * quad), eb2 = *(const LAS f32x4*)(EM + 32 * ks + 16 + 4 * quad);
                    const f32x4 x0 = S[2 * ks] * ea, x1 = S[2 * ks + 1] * eb2;
                    u32x4 p; p.x = cvt_pk_bf16(x0.x, x0.y); p.y = cvt_pk_bf16(x0.z, x0.w); p.z = cvt_pk_bf16(x1.x, x1.y); p.w = cvt_pk_bf16(x1.z, x1.w);
                    sf[ks] = __builtin_bit_cast(bf16x8, p);
                }
                __syncthreads();
#pragma unroll
                for (int tt = 0; tt < 4; ++tt) {
                    f32x4 acc = {0.f, 0.f, 0.f, 0.f};
#pragma unroll
                    for (int ks = 0; ks < 2; ++ks) { const bf16x8 pa = *(const LAS bf16x8*)(lds + HPB + (16 * tt + col) * 144 + ks * 64 + quad * 16); acc = __builtin_amdgcn_mfma_f32_16x16x32_bf16(pa, vf[ks], acc, 0, 0, 0); }
#pragma unroll
                    for (int ks = 0; ks < 4; ++ks) {
                        const u32x2 lo = *(const LAS u32x2*)(lds + HQE + (16 * tt + col) * 272 + (32 * ks + 4 * quad) * 2), hi = *(const LAS u32x2*)(lds + HQE + (16 * tt + col) * 272 + (32 * ks + 16 + 4 * quad) * 2);
                        const u32x4 qq = {lo.x, lo.y, hi.x, hi.y};
                        acc = __builtin_amdgcn_mfma_f32_16x16x32_bf16(__builtin_bit_cast(bf16x8, qq), sf[ks], acc, 0, 0, 0);
                    }
#pragma unroll
                    for (int r = 0; r < 4; ++r) OB[(16 * tt + 4 * quad + r) * 132 + 16 * wid + col] = acc[r];
                }
            }
#pragma unroll
            for (int kb = 0; kb < 8; ++kb) {
                const f32x4 e4 = *(const LAS f32x4*)(EB + 16 * kb + 4 * quad);
                f32x4 sacc = S[kb] * e4;
#pragma unroll
                for (int ks = 0; ks < 2; ++ks) { const bf16x8 ka = *(const LAS bf16x8*)(lds + HKDT + (16 * kb + col) * 144 + ks * 64 + quad * 16); sacc = __builtin_amdgcn_mfma_f32_16x16x32_bf16(ka, vf[ks], sacc, 0, 0, 0); }
                S[kb] = sacc;
            }
            __syncthreads();
            if (PASS == 2) {
                const int t = tid >> 3, vs = (tid & 7) * 16;
                float o[16]; float ss = 0.f;
#pragma unroll
                for (int i = 0; i < 4; ++i) { const f32x4 x = *(const LAS f32x4*)(OB + t * 132 + vs + 4 * i); o[4 * i] = x.x; o[4 * i + 1] = x.y; o[4 * i + 2] = x.z; o[4 * i + 3] = x.w; ss += (x.x * x.x + x.y * x.y) + (x.z * x.z + x.w * x.w); }
                ss += __shfl_xor(ss, 1); ss += __shfl_xor(ss, 2); ss += __shfl_xor(ss, 4);
                const float rstd = rsqrtf(ss * (1.f / 128.f) + EPS);
                u32x4* gp = (u32x4*)(Gb + (size_t)(b * 8192 + s0 + t) * DM + hh * 128 + vs);
                const float* gn = a.in[12] + vs;
#pragma unroll
                for (int hf = 0; hf < 2; ++hf) {
                    const u32x4 gw = hf ? gpre1 : gpre0; u32x4 ow;
                    const unsigned gws[4] = {gw.x, gw.y, gw.z, gw.w}; unsigned ows[4];
#pragma unroll
                    for (int i = 0; i < 4; ++i) { const int e = 8 * hf + 2 * i; ows[i] = cvt_pk_bf16(o[e] * rstd * gn[e] * bflo(gws[i]), o[e + 1] * rstd * gn[e + 1] * bfhi(gws[i])); }
                    ow.x = ows[0]; ow.y = ows[1]; ow.z = ows[2]; ow.w = ows[3]; if (!DRY || ow.x == 0x12345678u) gp[hf] = ow;
                }
            }
            if (ci + 1 < nchunk) {
#pragma unroll
                for (int i = 0; i < 16; ++i) fr16[i] = fn[i];
            }
        }
        if (PASS == 0) {
            float* sp = (meta ? STM + (size_t)hh * 16384 : ST + (size_t)u * 16384) + 16 * wid + col;
#pragma unroll
            for (int kb = 0; kb < 8; ++kb)
#pragma unroll
                for (int r = 0; r < 4; ++r) sp[(16 * kb + 4 * quad + r) * 128] = S[kb][r];
            if (!meta && tq == 0) HD[u * 128 + k] = __expf(btot);
        }
        __syncthreads();
    }
}
__device__ __forceinline__ void hg_pass_b(const Args& a) {
    float* ST = (float*)((unsigned char*)a.out + OUT_HGS); const float* STM = (const float*)(a.ws + WS_HGSM); const float* HD = (const float*)(a.ws + WS_HGD);
    for (int e = blockIdx.x * 512 + threadIdx.x; e < 16 * 16384; e += gridDim.x * 512) {
        const int bh = e >> 14, kv = e & 16383, k = kv >> 7, hh = bh & 7;
        float s = STM[hh * 16384 + kv];
#pragma unroll 8
        for (int j = 0; j < 32; ++j) { const int u = bh * 32 + j; const float d = ST[(size_t)u * 16384 + kv]; ST[(size_t)u * 16384 + kv] = s; s = HD[u * 128 + k] * s + d; }
    }
}


#ifndef RG_NAIVE
#define RG_NAIVE 0
#endif
#ifndef HG_NAIVE
#define HG_NAIVE 0
#endif
__device__ __forceinline__ void rg_naive(LAS unsigned char* lds, const Args& a) {
    if (blockIdx.x >= 32) return;
    const int b = blockIdx.x >> 4, n = blockIdx.x & 15, e = threadIdx.x, c = 80 * n + (e < 80 ? e : 0);
    LAS float* xs = (LAS float*)lds;
    const bf16_t* AX = (const bf16_t*)(a.ws + WS_AX); bf16_t* AG = (bf16_t*)(a.ws + WS_AG);
    float wa[80], wx[80];
#pragma unroll
    for (int d = 0; d < 80; ++d) { wa[d] = a.in[6][(size_t)n * 6400 + d * 80 + (e < 80 ? e : 0)]; wx[d] = a.in[8][(size_t)n * 6400 + d * 80 + (e < 80 ? e : 0)]; }
    const float ba = a.in[7][c], bx = a.in[9][c], sp = 8.f * log1pf(expf(-a.in[10][c])), cb = a.in[5][c];
    const float c0 = a.in[4][c], c1 = a.in[4][1280 + c], c2 = a.in[4][2560 + c], c3 = a.in[4][3840 + c];
    float h = 0.f, x0 = 0.f, x1 = 0.f, x2 = 0.f;
    for (int s = -16; s < 8192; ++s) {
        const float x3 = bf2f(AX[(size_t)tok_row(b, s) * RGW + c]);
        const float xc = cb + c0 * x0 + c1 * x1 + c2 * x2 + c3 * x3;
        x0 = x1; x1 = x2; x2 = x3;
        LAS float* xb = xs + (s & 1) * 80;
        if (e < 80) xb[e] = xc;
        __syncthreads();
        float r = ba, ii = bx;
#pragma unroll
        for (int d = 0; d < 80; ++d) { const float xv = xb[d]; r += xv * wa[d]; ii += xv * wx[d]; }
        const float la = -sp / (1.f + expf(-r)), av = expf(la), uu = sqrtf(-expm1f(2.f * la)) * xc / (1.f + expf(-ii));
        h = av * h + uu;
        if (s >= 0 && e < 80) { bf16_t* p = AG + (size_t)(b * 8192 + s) * RGW + c; *p = f2bf(h * bf2f(*p)); }
    }
    __syncthreads();
}
__device__ __forceinline__ void hg_naive(LAS unsigned char* lds, const Args& a) {
    if (blockIdx.x >= 16) return;
    const int b = blockIdx.x >> 3, hh = blockIdx.x & 7, v = threadIdx.x & 127; const bool act = threadIdx.x < 128;
    LAS float* fg = (LAS float*)lds; LAS float* kk = fg + 256; LAS float* qq = fg + 512; LAS float* red = fg + 768;
    const bf16_t* Fb = (const bf16_t*)(a.ws + WS_F); const bf16_t* Vb = (const bf16_t*)(a.ws + WS_V); const bf16_t* Qb = (const bf16_t*)(a.ws + WS_Q);
    bf16_t* Gb = (bf16_t*)((unsigned char*)a.out + OUT_G);
    const float lbv = 1.f / (1.f + expf(a.in[11][1024 + hh * 128 + v] - a.in[11][hh * 128 + v])), gn = a.in[12][v];
    float S[128];
#pragma unroll
    for (int k = 0; k < 128; ++k) S[k] = 0.f;
    for (int s = -16; s < 8192; ++s) {
        const int row = tok_row(b, s), par = (s & 1) * 128;
        const float fl = bf2f(Fb[(size_t)row * DM + hh * 128 + v]), sg = 1.f / (1.f + expf(-fl));
        const float vv = bf2f(Vb[(size_t)row * DM + hh * 128 + v]);
        if (act) { fg[par + v] = lbv + (1.f - lbv) * sg; kk[par + v] = (1.f - lbv) / (1.f + expf(fl)); qq[par + v] = s >= 0 ? bf2f(Qb[(size_t)row * DM + hh * 128 + v]) : 0.f; }
        __syncthreads();
        float o = 0.f;
#pragma unroll
        for (int k = 0; k < 128; ++k) { S[k] = fg[par + k] * S[k] + kk[par + k] * vv; o += S[k] * qq[par + k]; }
        const float ss = wave_sum(o * o);
        if ((threadIdx.x & 63) == 0 && act) red[(s & 1) * 2 + (threadIdx.x >> 6)] = ss;
        __syncthreads();
        if (s >= 0 && act) { const float tot = red[(s & 1) * 2] + red[(s & 1) * 2 + 1]; bf16_t* p = Gb + (size_t)(b * 8192 + s) * DM + hh * 128 + v; *p = f2bf(o * rsqrtf(tot * (1.f / 128.f) + EPS) * gn * bf2f(*p)); }
    }
    __syncthreads();
}

__device__ __forceinline__ u32x4 pack8(const f32x4& v0, const f32x4& v1) { u32x4 w; w.x = cvt_pk_bf16(v0[0], v0[1]); w.y = cvt_pk_bf16(v0[2], v0[3]); w.z = cvt_pk_bf16(v1[0], v1[1]); w.w = cvt_pk_bf16(v1[2], v1[3]); return w; }
struct EpiP1 {
    static constexpr bool PERM = true, AFTER_DRAIN = false;
    unsigned char* wsb; unsigned char* outb; int pn_off;
    __device__ __forceinline__ void operator()(const f32x4 (&acc)[2][2][4][2], const Unit& u, int wr, int wc, int fr, int fq) const {
        const int pn = u.pn + pn_off;
        const int seg = pn < 5 ? 0 : (pn < 10 ? 1 : (pn < 14 ? 2 : (pn < 18 ? 3 : (pn < 22 ? 4 : (pn < 26 ? 5 : (pn < 30 ? 6 : 7))))));
        const int ct = pn - (seg == 0 ? 0 : (seg == 1 ? 5 : (seg == 2 ? 10 : (seg == 3 ? 14 : (seg == 4 ? 18 : (seg == 5 ? 22 : (seg == 6 ? 26 : 30)))))));
        const int ld = seg < 2 ? RGW : DM, act = seg == 1 ? 1 : ((seg == 2 || seg == 5) ? 2 : (seg >= 6 ? 3 : 0));
        const size_t boff = seg == 0 ? WS_AX : (seg == 1 ? WS_AG : (seg == 2 ? WS_Q : (seg == 3 ? WS_F : (seg == 4 ? WS_V : (seg == 5 ? OUT_G : (seg == 6 ? WS_GA : WS_GB))))));
        bf16_t* base = (bf16_t*)((seg == 5 ? outb : wsb) + boff);
        if (act != 0 && u.pm >= 64) return;
        const float al = act == 1 ? 1.5957691216f : 1.f, be = act == 1 ? 0.0713548163f : 0.f;
        const int row0 = u.pm * 256 + wr * 64 + fr, col0 = ct * 256 + wc * 32 + 8 * fq;
#pragma unroll
        for (int ai = 0; ai < 2; ++ai)
#pragma unroll
            for (int m = 0; m < 4; ++m) { bf16_t* rowp = base + (size_t)(row0 + ai * 128 + m * 16) * ld + col0;
#pragma unroll
                for (int bj = 0; bj < 2; ++bj) { f32x4 v0 = acc[ai][bj][m][0], v1 = acc[ai][bj][m][1];
                    if (act) {
#pragma unroll
                        for (int i = 0; i < 4; ++i) { const float x = v0[i], y = v1[i]; const float sx = sigm(x * (al + be * x * x)), sy = sigm(y * (al + be * y * y)); v0[i] = act == 3 ? sx : x * sx; v1[i] = act == 3 ? sy : y * sy; } }
                    *(u32x4*)(rowp + bj * 128) = pack8(v0, v1); } }
    }
};
struct EpiGates {
    static constexpr bool PERM = true, AFTER_DRAIN = false;
    bf16_t *GA, *GB;
    __device__ __forceinline__ void operator()(const f32x4 (&acc)[2][2][4][2], const Unit& u, int wr, int wc, int fr, int fq) const {
        bf16_t* base = u.pn < 4 ? GA : GB; const int ct = u.pn & 3;
        const int row0 = u.pm * 256 + wr * 64 + fr, col0 = ct * 256 + wc * 32 + 8 * fq;
#pragma unroll
        for (int ai = 0; ai < 2; ++ai)
#pragma unroll
            for (int m = 0; m < 4; ++m) { bf16_t* rowp = base + (size_t)(row0 + ai * 128 + m * 16) * DM + col0;
#pragma unroll
                for (int bj = 0; bj < 2; ++bj) { f32x4 v0 = acc[ai][bj][m][0], v1 = acc[ai][bj][m][1];
#pragma unroll
                    for (int i = 0; i < 4; ++i) { v0[i] = sigm(v0[i]); v1[i] = sigm(v1[i]); }
                    *(u32x4*)(rowp + bj * 128) = pack8(v0, v1); } }
    }
};
#ifndef ZERO_A
#define ZERO_A 0
#endif
#ifndef ZERO_B
#define ZERO_B 0
#endif
template <int MODE> struct EpiMerge {
    static constexpr bool PERM = true, AFTER_DRAIN = false;
    const bf16_t* GT; const bf16_t* T1; bf16_t* O;
    __device__ __forceinline__ void operator()(const f32x4 (&acc)[2][2][4][2], const Unit& u, int wr, int wc, int fr, int fq) const {
        const int row0 = u.pm * 256 + wr * 64 + fr, col0 = u.pn * 256 + wc * 32 + 8 * fq;
#pragma unroll
        for (int ai = 0; ai < 2; ++ai)
#pragma unroll
            for (int m = 0; m < 4; ++m) { const size_t off = (size_t)(row0 + ai * 128 + m * 16) * DM + col0;
#pragma unroll
                for (int bj = 0; bj < 2; ++bj) { f32x4 v0 = acc[ai][bj][m][0], v1 = acc[ai][bj][m][1];
                    const u32x4 gw = *(const u32x4*)(GT + off + bj * 128);
                    v0[0] *= bflo(gw.x); v0[1] *= bfhi(gw.x); v0[2] *= bflo(gw.y); v0[3] *= bfhi(gw.y); v1[0] *= bflo(gw.z); v1[1] *= bfhi(gw.z); v1[2] *= bflo(gw.w); v1[3] *= bfhi(gw.w);
                    if ((MODE == 0 && ZERO_A) || (MODE == 1 && ZERO_B)) { v0 = (f32x4){0.f, 0.f, 0.f, 0.f}; v1 = v0; }
                    if (MODE == 1) { const u32x4 tw = *(const u32x4*)(T1 + off + bj * 128);
                        v0[0] += bflo(tw.x); v0[1] += bfhi(tw.x); v0[2] += bflo(tw.y); v0[3] += bfhi(tw.y); v1[0] += bflo(tw.z); v1[1] += bfhi(tw.z); v1[2] += bflo(tw.w); v1[3] += bfhi(tw.w); }
                    *(u32x4*)(O + off + bj * 128) = pack8(v0, v1); } }
    }
};
struct EpiRes {
    static constexpr bool PERM = false, AFTER_DRAIN = false;
    const float* base; float* out;
    __device__ __forceinline__ void operator()(const f32x4 (&acc)[2][2][4][2], const Unit& u, int wr, int wc, int fr, int fq) const {
        const int row0 = u.pm * 256 + wr * 64 + fr, col0 = u.pn * 256 + wc * 32 + 4 * fq;
#pragma unroll
        for (int ai = 0; ai < 2; ++ai)
#pragma unroll
            for (int m = 0; m < 4; ++m) { const size_t off = (size_t)(row0 + ai * 128 + m * 16) * DM + col0;
#pragma unroll
                for (int bj = 0; bj < 2; ++bj)
#pragma unroll
                    for (int n = 0; n < 2; ++n) { const f32x4 bs = *(const f32x4*)(base + off + bj * 128 + n * 16); *(f32x4*)(out + off + bj * 128 + n * 16) = bs + acc[ai][bj][m][n]; } }
    }
};
struct EpiRes1 {
    static constexpr bool PERM = false, AFTER_DRAIN = false;
    const float* base; float* out; bf16_t* A2; const float* g2; float* RS;
    __device__ __forceinline__ void operator()(const f32x4 (&acc)[2][2][4][2], const Unit& u, int wr, int wc, int fr, int fq) const {
        const int row0 = u.pm * 256 + wr * 64 + fr, col0 = u.pn * 256 + wc * 32 + 4 * fq;
        f32x4 gg[2][2];
#pragma unroll
        for (int bj = 0; bj < 2; ++bj)
#pragma unroll
            for (int n = 0; n < 2; ++n) gg[bj][n] = *(const f32x4*)(g2 + col0 + bj * 128 + n * 16);
#pragma unroll
        for (int ai = 0; ai < 2; ++ai)
#pragma unroll
            for (int m = 0; m < 4; ++m) { const int row = row0 + ai * 128 + m * 16; const size_t off = (size_t)row * DM + col0; float ss = 0.f;
#pragma unroll
                for (int bj = 0; bj < 2; ++bj)
#pragma unroll
                    for (int n = 0; n < 2; ++n) { const f32x4 h = *(const f32x4*)(base + off + bj * 128 + n * 16) + acc[ai][bj][m][n]; *(f32x4*)(out + off + bj * 128 + n * 16) = h;
                        ss += (h.x * h.x + h.y * h.y) + (h.z * h.z + h.w * h.w);
                        const f32x4 q = h * gg[bj][n]; u32x2 w; w.x = cvt_pk_bf16(q.x, q.y); w.y = cvt_pk_bf16(q.z, q.w); *(u32x2*)(A2 + off + bj * 128 + n * 16) = w; }
                ss += __shfl_xor(ss, 16); ss += __shfl_xor(ss, 32);
                if (fq == 0) atomicAdd(RS + row, ss); }
    }
};
struct EpiFfn {
    static constexpr bool PERM = true, AFTER_DRAIN = false;
    bf16_t* O; const float* RS;
    __device__ __forceinline__ void operator()(const f32x4 (&acc)[2][2][4][2], const Unit& u, int wr, int wc, int fr, int fq) const {
        const int row0 = u.pm * 256 + wr * 64 + fr, col0 = u.pn * 128 + wc * 32 + 8 * fq;
#pragma unroll
        for (int ai = 0; ai < 2; ++ai)
#pragma unroll
            for (int m = 0; m < 4; ++m) { f32x4 v0, v1; const int row = row0 + ai * 128 + m * 16;
                const float rstd = rsqrtf(__hip_atomic_load(RS + row, __ATOMIC_RELAXED, __HIP_MEMORY_SCOPE_AGENT) * (1.f / 1024.f) + EPS);
#pragma unroll
                for (int i = 0; i < 4; ++i) { const float g0 = acc[ai][0][m][0][i] * rstd, g1 = acc[ai][0][m][1][i] * rstd; v0[i] = g0 * sigm(g0) * (acc[ai][1][m][0][i] * rstd); v1[i] = g1 * sigm(g1) * (acc[ai][1][m][1][i] * rstd); }
                *(u32x4*)(O + (size_t)row * DFF + col0) = pack8(v0, v1); }
    }
};

#ifndef SELFCHECK
#define SELFCHECK 0
#endif
constexpr size_t WS_RS1 = 65536;
constexpr size_t WS_FLAGS = 512 * 1024;
__device__ __forceinline__ unsigned hash32(unsigned x) { x ^= x >> 16; x *= 0x7feb352du; x ^= x >> 15; x *= 0x846ca68bu; x ^= x >> 16; return x; }
__device__ __forceinline__ float dot_bf_w(const bf16_t* arow, const float* W, int K, int N, int col, int lane) {
    float s = 0.f; for (int k = lane; k < K; k += 64) s += bf2f(arow[k]) * W[(size_t)k * N + col]; return wave_sum(s);
}
__device__ __forceinline__ void flag_err(unsigned char* ws, int p, float got, float ref, int lane) {
    const float e = fabsf(got - ref) / (fabsf(ref) + 0.5f);
    if (lane == 0) atomicMax((unsigned*)(ws + WS_FLAGS) + p, __float_as_uint(e != e ? 1e9f : e));
}
__device__ __forceinline__ float act_f(float x, int act) { return act == 0 ? x : (act == 1 ? 0.5f * x * (1.f + tanhf(0.7978845608f * (x + 0.044715f * x * x * x))) : x / (1.f + expf(-x))); }
template <int PH> __device__ __forceinline__ void selfcheck(const Args& a) {
    unsigned char* ws = a.ws; const int lane = threadIdx.x & 63, gw = blockIdx.x * 8 + (threadIdx.x >> 6);
    const bf16_t* XN = (const bf16_t*)(ws + WS_XN);
    for (int smp = 0; smp < 4; ++smp) {
        const unsigned hsh = hash32((unsigned)(gw * 4 + smp) * 2654435761u + PH * 977u);
        if (PH == 1) {
            const int col = hsh % N1; int row = (hsh >> 13) % (MX + (SELFCHECK == 1 ? 16 : 0));
            const int seg = col < 1280 ? 0 : (col < 2560 ? 1 : (col < 3584 ? 2 : (col < 4608 ? 3 : (col < 5632 ? 4 : 5))));
            const int act = seg == 1 ? 1 : ((seg == 2 || seg == 5) ? 2 : 0);
            if (act != 0 && row >= MX) row -= 64;
            const float ref = act_f(dot_bf_w(XN + (size_t)row * DM, a.in[3], DM, 8704, col, lane), act);
            const size_t boff = seg == 0 ? WS_AX : (seg == 1 ? WS_AG : (seg == 2 ? WS_Q : (seg == 3 ? WS_F : (seg == 4 ? WS_V : OUT_G))));
            const bf16_t* base = (const bf16_t*)((seg == 5 ? (unsigned char*)a.out : ws) + boff);
            const int ld = seg < 2 ? RGW : DM, c0 = seg == 0 ? 0 : (seg == 1 ? 1280 : (seg == 2 ? 2560 : (seg == 3 ? 3584 : (seg == 4 ? 4608 : 5632))));
            flag_err(ws, 0 + seg, bf2f(base[(size_t)row * ld + col - c0]), ref, lane);
        }
        if (PH == 2) {
            const int col = hsh % 2048, row = (hsh >> 13) % MX;
            const float ref = 1.f / (1.f + expf(-dot_bf_w(XN + (size_t)row * DM, a.in[3], DM, 8704, N1 + col, lane)));
            const bf16_t* base = col < 1024 ? (const bf16_t*)(ws + WS_GA) : (const bf16_t*)(ws + WS_GB);
            const float got = bf2f(base[(size_t)row * DM + (col & 1023)]);
            flag_err(ws, 6, got, ref, lane);
            const bf16_t* wr = (const bf16_t*)(ws + WS_WIN) + (size_t)(N1 + col) * DM; float s2 = 0.f;
            for (int k = lane; k < DM; k += 64) s2 += bf2f(XN[(size_t)row * DM + k]) * bf2f(wr[k]);
            const float ref2 = 1.f / (1.f + expf(-wave_sum(s2)));
            flag_err(ws, 16, ref2, ref, lane);
            flag_err(ws, 17, got, ref2, lane);
            if (lane == 0 && !(fabsf(got - ref) < 0.03f)) { atomicAdd((unsigned*)(ws + WS_FLAGS) + 20, 1u); if (got > 1.01f || got < -0.01f) atomicAdd((unsigned*)(ws + WS_FLAGS) + 21, 1u); }
        }
        if (PH == 3) {
            const int col = hsh % 1024, row = (hsh >> 13) % MX;
            const float pa = dot_bf_w((const bf16_t*)(ws + WS_AG) + (size_t)row * RGW, a.in[13], RGW, DM, col, lane);
            const float pb = dot_bf_w((const bf16_t*)((unsigned char*)a.out + OUT_G) + (size_t)row * DM, a.in[14], DM, DM, col, lane);
            const float ref = bf2f(((const bf16_t*)(ws + WS_GA))[(size_t)row * DM + col]) * pa + bf2f(((const bf16_t*)(ws + WS_GB))[(size_t)row * DM + col]) * pb;
            flag_err(ws, 7, bf2f(((const bf16_t*)(ws + WS_MG))[(size_t)row * DM + col]), ref, lane);
        }
        if (PH == 4) {
            const int col = hsh % 1024, row = (hsh >> 13) % MX;
            const float ref = a.in[0][(size_t)row * DM + col] + dot_bf_w((const bf16_t*)(ws + WS_MG) + (size_t)row * DM, a.in[15], DM, DM, col, lane);
            flag_err(ws, 8, a.out[(size_t)row * DM + col], ref, lane);
        }
        if (PH == 5) {
            const int col = hsh % 1024, row = (hsh >> 13) % MX; float s2 = 0.f;
            for (int k = lane; k < DM; k += 64) { const float v = a.out[(size_t)row * DM + k]; s2 += v * v; }
            const float ref = a.out[(size_t)row * DM + col] * rsqrtf(wave_sum(s2) / 1024.f + EPS) * a.in[16][col];
            flag_err(ws, 9, bf2f(XN[(size_t)row * DM + col]), ref, lane);
        }
        if (PH == 6) {
            const int col = hsh % DFF, row = (hsh >> 13) % MX;
            const float gg = dot_bf_w(XN + (size_t)row * DM, a.in[17], DM, 2 * DFF, col, lane), uu = dot_bf_w(XN + (size_t)row * DM, a.in[17], DM, 2 * DFF, DFF + col, lane);
            flag_err(ws, 10, bf2f(((const bf16_t*)(ws + WS_AG))[(size_t)row * DFF + col]), act_f(gg, 2) * uu, lane);
        }
        if (PH == 7) {
            const int col = hsh % 1024, row = (hsh >> 13) % MX;
            const float ref = a.in[0][(size_t)row * DM + col] + dot_bf_w((const bf16_t*)(ws + WS_AX) + (size_t)row * DM, a.in[15], DM, DM, col, lane)
                            + dot_bf_w((const bf16_t*)(ws + WS_AG) + (size_t)row * DFF, a.in[18], DFF, DM, col, lane);
            flag_err(ws, 11, a.out[(size_t)row * DM + col], ref, lane);
        }
    }
}

#define LDS_WAIT2() asm volatile("s_waitcnt lgkmcnt(0)" ::: "memory")
#define XB_TMO      128
#define XB_XCNT(j)  (256  + 64 * (j))
#define XB_XSUB(j)  (1280 + 64 * (j))
#define XB_XGEN(j)  (2304 + 64 * (j))
#define XB_TOP      3328
#define XB_TOPGEN   3392
#define XCD_BAR_WORDS 3456
#define XB_SPIN_CAP (1u << 18)

__device__ __forceinline__ unsigned xb_ld(unsigned* p)              { return __hip_atomic_load(p, __ATOMIC_RELAXED, __HIP_MEMORY_SCOPE_AGENT); }
__device__ __forceinline__ unsigned xb_add(unsigned* p, unsigned v) { return __hip_atomic_fetch_add(p, v, __ATOMIC_RELAXED, __HIP_MEMORY_SCOPE_AGENT); }
__device__ __forceinline__ unsigned xb_xcc_id() { return (unsigned)__builtin_amdgcn_s_getreg((3 << 11) | 20) & 0xFu; }
#define XB_SPIN(cond, bar) do { unsigned _sp = 0; while (cond) { __builtin_amdgcn_s_sleep(1); \
    if ((++_sp & 255u) == 0u) { if (xb_ld(&(bar)[XB_TMO])) break; if (_sp > XB_SPIN_CAP) { atomicAdd(&(bar)[XB_TMO], 1u); break; } } } } while (0)

struct XcdBarrier {
    unsigned* bar; unsigned x;
    volatile LAS unsigned* st;
};

__device__ __forceinline__ XcdBarrier xcd_barrier_post(unsigned* bar, volatile LAS unsigned* st) {
    XcdBarrier b; b.bar = bar; b.x = xb_xcc_id(); b.st = st;
    if (threadIdx.x == 0) (void)xb_add(&bar[XB_XCNT(b.x)], 1u);
    return b;
}
__device__ __forceinline__ void xcd_barrier_complete(unsigned* bar, unsigned x, unsigned& nloc, unsigned& nx) {
    const unsigned G = gridDim.x * gridDim.y * gridDim.z;
    unsigned sum, cnt, mine, sp = 0u;
    for (;;) {
        sum = 0u; cnt = 0u; mine = 0u;
#pragma unroll
        for (unsigned j = 0; j < 16; ++j) { const unsigned c = xb_ld(&bar[XB_XCNT(j)]); sum += c; cnt += (c > 0u) ? 1u : 0u; mine = (j == x) ? c : mine; }
        if (sum == G) break;
        __builtin_amdgcn_s_sleep(1);
        if ((++sp & 255u) == 0u) { if (xb_ld(&bar[XB_TMO])) break; if (sp > XB_SPIN_CAP) { atomicAdd(&bar[XB_TMO], 1u); break; } }
    }
    nloc = mine > 0u ? mine : 1u; nx = cnt > 0u ? cnt : 1u;
}

__device__ __forceinline__ void xcd_barrier(const XcdBarrier& b) {
    asm volatile("s_waitcnt vmcnt(0)" ::: "memory");
    __syncthreads();
    if (threadIdx.x == 0) {
        unsigned* bar = b.bar;
        __builtin_amdgcn_s_waitcnt(0);
        unsigned nloc = b.st[0], nx = b.st[1];
        if (nloc == 0u) { xcd_barrier_complete(bar, b.x, nloc, nx); b.st[0] = nloc; b.st[1] = nx; }
        const unsigned old = xb_add(&bar[XB_XSUB(b.x)], 1u);
        const unsigned gen = old / nloc;
        if (old + 1u == (gen + 1u) * nloc) {
            __builtin_amdgcn_fence(__ATOMIC_RELEASE, "agent");
            asm volatile("s_waitcnt vmcnt(0)" ::: "memory");
            const unsigned og = xb_add(&bar[XB_TOP], 1u);
            const unsigned tg = og / nx;
            if (og + 1u == (tg + 1u) * nx) xb_add(&bar[XB_TOPGEN], 1u);
            else XB_SPIN(xb_ld(&bar[XB_TOPGEN]) == tg, bar);
            __builtin_amdgcn_fence(__ATOMIC_ACQUIRE, "agent");
            xb_add(&bar[XB_XGEN(b.x)], 1u);
            asm volatile("s_waitcnt vmcnt(0)" ::: "memory");
        } else {
            XB_SPIN(xb_ld(&bar[XB_XGEN(b.x)]) == gen, bar);
            __builtin_amdgcn_fence(__ATOMIC_ACQUIRE, "agent");
            asm volatile("s_waitcnt vmcnt(0)" ::: "memory");
        }
    }
    __syncthreads();
}

#ifndef N_LAUNCH
#define N_LAUNCH 1
#endif
__global__ void __launch_bounds__(512, 2) mega(Args a) {
    extern __shared__ __attribute__((aligned(16))) unsigned char lds_raw[];
    LAS unsigned char* lds = (LAS unsigned char*)lds_raw;
    cg::grid_group grid = cg::this_grid();
    const int lo = a.ph_lo, hi = a.ph_hi;
    volatile LAS unsigned* xst = (volatile LAS unsigned*)(lds + 143360);
    if (threadIdx.x < 2) xst[threadIdx.x] = 0u;
    __syncthreads();
    XcdBarrier xbar = xcd_barrier_post((unsigned*)a.ws, xst);
    if (a.ph_lo < 0) grid.sync();
#define IN(k) (lo <= (k) && (k) < hi)
#define SEAM(k) do { if (IN(k) && hi > (k) + 1) { xcd_barrier(xbar); } } while (0)
    unsigned char* ws = a.ws; const int G = gridDim.x, bid = blockIdx.x;
    bf16_t* XN = (bf16_t*)(ws + WS_XN);
    if (IN(0)) p0_prologue(lds, a);
    if (SELFCHECK && bid == 0 && threadIdx.x < 64) ((unsigned*)(ws + WS_FLAGS))[threadIdx.x] = 0u;
    SEAM(0);
    if (IN(1)) { pg8::Gemm g{XN, (const bf16_t*)(ws + WS_WIN), MT, N1, DM}; pg8::StaticOrder S; S.init(MT, N1, G, bid);
      EpiP1 E{ws, (unsigned char*)a.out, 0};
      pg8::gemm_phase<EpiP1, pg8::StaticOrder, true, true>(lds, g, S, E);
      __syncthreads();
      if (bid >= 154) p0_late_weights(lds, a, (bid - 154) * 8 + (threadIdx.x >> 6), 102 * 8); }
    SEAM(1);
    if (SELFCHECK) { selfcheck<1>(a); __threadfence(); grid.sync(); __threadfence(); }
    if (IN(2)) { if (!RG_NAIVE) rg_pass<1>(lds, a); if (!HG_NAIVE) hg_pass<0>(lds, a); }
    SEAM(2);
    if (IN(3)) { hg_pass_b(a); rg_pass<2>(lds, a); }
    SEAM(3);
    if (IN(4)) { hg_pass<2>(lds, a); }
    SEAM(4);
    if (IN(6)) { pg8::StaticOrder S; S.init(MX, DM, G, bid);
      { pg8::Gemm g{XN, (const bf16_t*)(ws + WS_WIN) + (size_t)N1 * DM, MX, DM, DM};
        EpiP1 E{ws, (unsigned char*)a.out, 26};
        pg8::gemm_phase<EpiP1, pg8::StaticOrder, false, true>(lds, g, S, E); }
      __syncthreads();
      { pg8::Gemm g{(const bf16_t*)(ws + WS_AG), (const bf16_t*)(ws + WS_WPA), MX, DM, RGW};
        EpiMerge<0> E{(const bf16_t*)(ws + WS_GA), nullptr, (bf16_t*)(ws + WS_T1)};
        pg8::gemm_phase<EpiMerge<0>, pg8::StaticOrder, false, true>(lds, g, S, E); }
      __syncthreads();
      { pg8::Gemm g{XN, (const bf16_t*)(ws + WS_WIN) + (size_t)(N1 + 1024) * DM, MX, DM, DM};
        EpiP1 E{ws, (unsigned char*)a.out, 30};
        pg8::gemm_phase<EpiP1, pg8::StaticOrder, false, true>(lds, g, S, E); }
      __syncthreads();
      { pg8::Gemm g{(const bf16_t*)((unsigned char*)a.out + OUT_G), (const bf16_t*)(ws + WS_WPB), MX, DM, DM};
        EpiMerge<1> E{(const bf16_t*)(ws + WS_GB), (const bf16_t*)(ws + WS_T1), (bf16_t*)(ws + WS_MG)};
        pg8::gemm_phase<EpiMerge<1>, pg8::StaticOrder, false, true>(lds, g, S, E); } }
    SEAM(6);
    if (SELFCHECK) { selfcheck<3>(a); __threadfence(); grid.sync(); __threadfence(); }
    if (IN(7)) { pg8::Gemm g{(const bf16_t*)(ws + WS_MG), (const bf16_t*)(ws + WS_WOUT), MX, DM, DM}; pg8::StaticOrder S; S.init(MX, DM, G, bid);
      EpiRes1 E{a.in[0], a.out, XN, a.in[16], (float*)(ws + WS_RS1)};
      pg8::gemm_phase<EpiRes1, pg8::StaticOrder, false, true>(lds, g, S, E); }
    SEAM(7);
    if (IN(9)) { pg8::Gemm g{XN, (const bf16_t*)(ws + WS_WFI), MX, 2 * DFF, DM}; pg8::StaticOrder S; S.init(MX, 2 * DFF, G, bid);
      EpiFfn E{(bf16_t*)(ws + WS_AG), (const float*)(ws + WS_RS1)};
      pg8::gemm_phase<EpiFfn, pg8::StaticOrder, true, true>(lds, g, S, E); }
    SEAM(9);
    if (SELFCHECK) { selfcheck<6>(a); __threadfence(); grid.sync(); __threadfence(); }
    if (IN(10)) { pg8::Gemm g{(const bf16_t*)(ws + WS_AG), (const bf16_t*)(ws + WS_WFD), MX, DM, DFF}; pg8::StaticOrder S; S.init(MX, DM, G, bid);
      EpiRes E{a.out, a.out};
      pg8::gemm_phase<EpiRes, pg8::StaticOrder, false, true>(lds, g, S, E); }
    SEAM(10);
    if (SELFCHECK) { selfcheck<7>(a); __threadfence(); grid.sync(); __threadfence(); }
    if (IN(11)) { for (int m = bid * 8 + __builtin_amdgcn_readfirstlane(threadIdx.x >> 6); m < MX; m += G * 8) {
        const int lane = (int)__lane_id();
        float* row = a.out + (size_t)m * DM; f32x4 v[4]; float s = 0.f;
#pragma unroll
        for (int j = 0; j < 4; ++j) { v[j] = ((const f32x4*)row)[lane + 64 * j]; s += (v[j].x * v[j].x + v[j].y * v[j].y) + (v[j].z * v[j].z + v[j].w * v[j].w); }
        const float rstd = rsqrtf(wave_sum(s) * (1.f / 1024.f) + EPS);
#pragma unroll
        for (int j = 0; j < 4; ++j) { const f32x4 gg = ((const f32x4*)a.in[19])[lane + 64 * j]; ((f32x4*)row)[lane + 64 * j] = v[j] * rstd * gg; }
    } }
    if (SELFCHECK) { __threadfence(); grid.sync(); __threadfence(); if (bid == 0 && threadIdx.x == 0) { const unsigned* fl = (const unsigned*)(ws + WS_FLAGS);
        const int mask = (__uint_as_float(fl[6]) > 0.05f ? 1 : 0) + (__uint_as_float(fl[16]) > 0.05f ? 2 : 0) + (__uint_as_float(fl[17]) > 0.05f ? 4 : 0) + (fl[21] > 0 ? 8 : 0);
        const int kk = 1 + (int)fl[20]; for (int i = 0; i < kk; ++i) a.out[i] = 1000.f * (1 + mask); } }
}

extern "C" void kernel_launch(void* const* d_in, const int* in_sizes, int n_in, void* d_out, int out_size, void* d_ws, size_t ws_size, hipStream_t stream) {
    static int ok = 0;
    if (!ok) { (void)hipFuncSetAttribute((const void*)mega, hipFuncAttributeMaxDynamicSharedMemorySize, LDS_BYTES); ok = 1; }
    Args a{};
    for (int i = 0; i < 20; ++i) a.in[i] = (const float*)d_in[i];
    a.out = (float*)d_out; a.ws = (unsigned char*)d_ws;
    if (N_LAUNCH == 1) {
        (void)hipMemsetAsync(d_ws, 0, 131072, stream);
        a.ph_lo = 0; a.ph_hi = 12;
        void* args[] = {&a};
        hipError_t e = hipLaunchCooperativeKernel((const void*)mega, dim3(256), dim3(512), args, LDS_BYTES, stream);
        if (e != hipSuccess) fprintf(stderr, "cooperative launch failed: %s\n", hipGetErrorString(e));
    } else {
        for (int k = 0; k < 12; ++k) { a.ph_lo = k; a.ph_hi = k + 1; hipLaunchKernelGGL(mega, dim3(256), dim3(512), LDS_BYTES, stream, a); }
    }
}
```
